# Optimizing an MI355X kernel written in HIP

```python
import math
import jax
import jax.numpy as jnp
from jax import lax
import numpy as np

D_MODEL = 1024
BATCH = 2
SEQ = 16384
DEPTH = 4

GRID_W = 64
CTX_LEN = 256
N_MIXERS = 4
EPS = 1e-6

GMLP_CHUNK = 128
GMLP_WIDTH = 2 * D_MODEL
GMLP_GROUPS = 8

LRU_WIDTH = D_MODEL
LRU_HEADS = 8
LRU_HEAD_DIM = LRU_WIDTH // LRU_HEADS
LRU_CONV = 4
LRU_C = 8.0

HYENA_WIDTH = D_MODEL
HYENA_ORDER = 2
HYENA_CONV = 3
HYENA_BANDS = 16
HYENA_EMB = 2 * HYENA_BANDS + 1
HYENA_FILTER_HIDDEN = 64
HYENA_FAST_DECAY = 0.3
HYENA_SLOW_DECAY = 1.5
HYENA_DECAY_TARGET = 1e-2

POOL_WIDTH = D_MODEL
POOL_WINDOWS = (2, 4, 8, 16)
POOL_GROUP = POOL_WIDTH // len(POOL_WINDOWS)

D_FF = 2816
N_EXPERTS = 8
TOP_K = 2
EXPERT_FF = 3584

kernel_name = 'hybrid_interleaved_diffusion_block'


def _n_uses(first, period):
    return len(range(first, DEPTH, period))


def rmsnorm(x, g):
    x32 = x.astype(jnp.float32)
    y = x32 * lax.rsqrt(jnp.mean(x32 * x32, axis=-1, keepdims=True) + EPS)
    return (y * g.astype(jnp.float32)).astype(x.dtype)


def layernorm(x, g):
    x32 = x.astype(jnp.float32)
    mu = jnp.mean(x32, axis=-1, keepdims=True)
    xc = x32 - mu
    y = xc * lax.rsqrt(jnp.mean(xc * xc, axis=-1, keepdims=True) + EPS)
    return (y * g.astype(jnp.float32)).astype(x.dtype)


def modulate(x, shift, scale):
    return x * (1.0 + scale) + shift


def grid_pos_embed(rows, dtype):
    r, col = jnp.meshgrid(jnp.arange(rows, dtype=jnp.float32),
                          jnp.arange(GRID_W, dtype=jnp.float32), indexing='ij')
    quarter = D_MODEL // 4
    omega = 1.0 / (10000.0 ** (jnp.arange(quarter, dtype=jnp.float32) / quarter))

    def sincos(p):
        ang = p.reshape(-1, 1) * omega[None, :]
        return jnp.concatenate([jnp.sin(ang), jnp.cos(ang)], axis=-1)

    return jnp.concatenate([sincos(r), sincos(col)], axis=-1).astype(dtype)


def depthwise_conv_centred(x, w, b):
    K = w.shape[0]
    L = x.shape[1]
    left = K // 2
    xp = jnp.pad(x, ((0, 0), (left, K - 1 - left), (0, 0)))
    y = b
    for k in range(K):
        y = y + xp[:, k:k + L] * w[k]
    return y


def gmlp_mixer(h, w_in, g_v, w_s, b_s, w_out):
    B, L, _ = h.shape
    u, v = jnp.split(jax.nn.gelu(h @ w_in), 2, axis=-1)
    v = layernorm(v, g_v)
    v = v.reshape(B, L // GMLP_CHUNK, GMLP_CHUNK, GMLP_GROUPS, GMLP_WIDTH // GMLP_GROUPS)
    v = jnp.einsum('gts,bnsgc->bntgc', w_s, v) + b_s.T[:, :, None]
    return (u * v.reshape(B, L, GMLP_WIDTH)) @ w_out


def rglru_scan(x, w_a, b_a, w_x, b_x, lam, h0, reverse):
    B, L, W = x.shape
    xh = x.reshape(B, L, LRU_HEADS, LRU_HEAD_DIM)
    r = jax.nn.sigmoid(jnp.einsum('blhi,hij->blhj', xh, w_a).reshape(B, L, W).astype(jnp.float32) + b_a)
    i = jax.nn.sigmoid(jnp.einsum('blhi,hij->blhj', xh, w_x).reshape(B, L, W).astype(jnp.float32) + b_x)
    log_a = -LRU_C * r * jax.nn.softplus(-lam.astype(jnp.float32))
    a = jnp.exp(log_a)
    b = jnp.sqrt(-jnp.expm1(2.0 * log_a)) * (i * x.astype(jnp.float32))
    if h0 is not None:
        first = L - 1 if reverse else 0
        b = b.at[:, first].add(a[:, first] * h0)

    def combine(e1, e2):
        a1, b1 = e1
        a2, b2 = e2
        return a1 * a2, a2 * b1 + b2

    _, hs = lax.associative_scan(combine, (a, b), axis=1, reverse=reverse)
    return hs


def lru_mixer(h_lat, h_ctx, w_in, conv_w, conv_b, w_a, b_a, w_x, b_x, lam, w_out, ctx_out):
    def scans(xb, s_f, s_b):
        hf = rglru_scan(xb, w_a[0], b_a[0], w_x[0], b_x[0], lam[0], s_f, False)
        hb = rglru_scan(xb, w_a[1], b_a[1], w_x[1], b_x[1], lam[1], s_b, True)
        return hf, hb

    gate_c, xb_c = jnp.split(h_ctx @ w_in, 2, axis=-1)
    hf_c, hb_c = scans(depthwise_conv_centred(xb_c, conv_w, conv_b), None, None)
    gate_l, xb_l = jnp.split(h_lat @ w_in, 2, axis=-1)
    hf_l, hb_l = scans(depthwise_conv_centred(xb_l, conv_w, conv_b), hf_c[:, -1], hb_c[:, 0])
    g_l = jax.nn.gelu(gate_l)
    y_lat = (g_l * (hf_l + hb_l).astype(g_l.dtype)) @ w_out
    y_ctx = None
    if ctx_out:
        g_c = jax.nn.gelu(gate_c)
        y_ctx = (g_c * (hf_c + hb_c).astype(g_c.dtype)) @ w_out
    return y_lat, y_ctx


def hyena_filters(L, f_w1, f_b1, f_w2, f_b2, f_w3, f_b3, f_freq, f_wout):
    f32 = jnp.float32
    t = jnp.linspace(0.0, 1.0, L, dtype=f32)[:, None]
    w = 2.0 * math.pi * jnp.arange(L, dtype=f32)[:, None] / L
    bands = jnp.linspace(1e-4, HYENA_BANDS - 1, HYENA_BANDS, dtype=f32)[None, :]
    z = jnp.concatenate([t, jnp.cos(bands * w), jnp.sin(-bands * w)], axis=-1)
    fr = f_freq.astype(f32)
    hdn = jnp.sin(fr[0] * (z @ f_w1.astype(f32) + f_b1.astype(f32)))
    hdn = jnp.sin(fr[1] * (hdn @ f_w2.astype(f32) + f_b2.astype(f32)))
    hdn = jnp.sin(fr[2] * (hdn @ f_w3.astype(f32) + f_b3.astype(f32)))
    filt = (hdn @ f_wout.astype(f32)).reshape(L, HYENA_ORDER, 2, HYENA_WIDTH)
    max_decay = math.log(HYENA_DECAY_TARGET) / HYENA_FAST_DECAY
    min_decay = math.log(HYENA_DECAY_TARGET) / HYENA_SLOW_DECAY
    deltas = jnp.abs(jnp.linspace(min_decay, max_decay, HYENA_WIDTH, dtype=f32))
    window = jnp.exp(-t * deltas[None, :])
    return filt * window[:, None, None, :]


def two_sided_long_conv(v, h_fwd, h_bwd, bias):
    B, L, C = v.shape
    v32 = v.astype(jnp.float32)
    k = jnp.concatenate([h_fwd, jnp.zeros((1, C), jnp.float32), h_bwd[:0:-1]], axis=0)
    n = 2 * L
    y = jnp.fft.irfft(jnp.fft.rfft(v32, n=n, axis=1) * jnp.fft.rfft(k, n=n, axis=0)[None], n=n, axis=1)[:, :L]
    return y + v32 * bias.astype(jnp.float32)


def hyena_mixer(h, w_in, conv_w, conv_b, f_w1, f_b1, f_w2, f_b2, f_w3, f_b3, f_freq, f_wout, bias, w_out):
    B, L, _ = h.shape
    z = depthwise_conv_centred(h @ w_in, conv_w, conv_b).astype(jnp.float32)
    x1, x2, v = jnp.split(z, 3, axis=-1)
    filt = hyena_filters(L, f_w1, f_b1, f_w2, f_b2, f_w3, f_b3, f_freq, f_wout)
    y = v
    for o, gate in enumerate((x1, x2)):
        y = gate * two_sided_long_conv(y, filt[:, o, 0], filt[:, o, 1], bias[o])
    return y.astype(h.dtype) @ w_out


def pool_mixer(h, w_in, w_g, b_g, scale, w_out):
    B, L, _ = h.shape
    G = len(POOL_WINDOWS)
    p = (h @ w_in).astype(jnp.float32).reshape(B, L, G, POOL_GROUP)
    S = jnp.concatenate([jnp.zeros((B, 1, G, POOL_GROUP), jnp.float32), jnp.cumsum(p, axis=1)], axis=1)
    t = jnp.arange(L)
    pooled = []
    for g, win in enumerate(POOL_WINDOWS):
        lo = jnp.clip(t - win // 2, 0, L)
        hi = jnp.clip(t + win // 2, 0, L)
        cnt = (hi - lo).astype(jnp.float32)[None, :, None]
        Sg = S[:, :, g]
        pooled.append((Sg[:, hi] - Sg[:, lo]) / cnt - p[:, :, g])
    q = jnp.stack(pooled, axis=2)
    y = jnp.einsum('blgc,gcd->blgd', q, w_g.astype(jnp.float32)) + b_g.astype(jnp.float32)
    y = y.reshape(B, L, POOL_WIDTH) * scale.astype(jnp.float32)
    return y.astype(h.dtype) @ w_out


def swiglu(h, w_gate, w_up, w_down):
    return (jax.nn.silu(h @ w_gate) * (h @ w_up)) @ w_down


def moe_ffn(h, w_router, w_gate, w_up, w_down):
    shape = h.shape
    hf = h.reshape(-1, shape[-1])
    logits = (hf @ w_router).astype(jnp.float32)
    top_val, top_idx = lax.top_k(logits, TOP_K)
    probs = jax.nn.softmax(top_val, axis=-1)
    combine = jnp.sum(jax.nn.one_hot(top_idx, N_EXPERTS, dtype=jnp.float32) * probs[..., None], axis=1)
    out = jnp.zeros_like(hf)
    for e in range(N_EXPERTS):
        out = out + combine[:, e:e + 1].astype(hf.dtype) * swiglu(hf, w_gate[e], w_up[e], w_down[e])
    return out.reshape(shape)


def setup_inputs(seed: int = 0) -> dict:
    key = jax.random.key(seed)
    keys = iter(jax.random.split(key, 64))
    f32 = jnp.float32

    def nrm(shape, scale):
        return jax.random.normal(next(keys), shape, f32) * scale

    D = D_MODEL
    nA, nB, nC, nD = (_n_uses(k, N_MIXERS) for k in range(N_MIXERS))
    nF, nM = _n_uses(0, 2), _n_uses(1, 2)
    inp = {}
    inp['x'] = nrm((BATCH, SEQ, D), 1.0)
    inp['c'] = nrm((BATCH, D), 1.0)
    inp['ctx'] = nrm((BATCH, CTX_LEN, D), 1.0)
    inp['c_ctx'] = nrm((D,), 1.0)
    inp['ada_w'] = nrm((DEPTH, D, 6 * D), 0.5 * D ** -0.5)
    inp['ada_b'] = nrm((DEPTH, 6 * D), 0.02)
    inp['norm_g'] = 1.0 + nrm((DEPTH, 4, D), 0.05)
    inp['gmlp_w_in'] = nrm((nA, D, 2 * GMLP_WIDTH), D ** -0.5)
    inp['gmlp_g_v'] = 1.0 + nrm((nA, GMLP_WIDTH), 0.05)
    inp['gmlp_w_s'] = nrm((nA, GMLP_GROUPS, GMLP_CHUNK, GMLP_CHUNK), GMLP_CHUNK ** -0.5)
    inp['gmlp_b_s'] = 1.0 + nrm((nA, GMLP_GROUPS, GMLP_CHUNK), 0.02)
    inp['gmlp_w_out'] = nrm((nA, GMLP_WIDTH, D), GMLP_WIDTH ** -0.5)
    inp['lru_w_in'] = nrm((nB, D, 2 * LRU_WIDTH), D ** -0.5)
    inp['lru_conv_w'] = nrm((nB, LRU_CONV, LRU_WIDTH), LRU_CONV ** -0.5)
    inp['lru_conv_b'] = nrm((nB, LRU_WIDTH), 0.02)
    inp['lru_w_a'] = nrm((nB, 2, LRU_HEADS, LRU_HEAD_DIM, LRU_HEAD_DIM), LRU_HEAD_DIM ** -0.5)
    inp['lru_b_a'] = nrm((nB, 2, LRU_WIDTH), 0.02)
    inp['lru_w_x'] = nrm((nB, 2, LRU_HEADS, LRU_HEAD_DIM, LRU_HEAD_DIM), LRU_HEAD_DIM ** -0.5)
    inp['lru_b_x'] = nrm((nB, 2, LRU_WIDTH), 0.02)
    u = jax.random.uniform(next(keys), (nB, 2, LRU_WIDTH), f32, minval=0.9, maxval=0.999)
    a = u ** (1.0 / LRU_C)
    inp['lru_lam'] = jnp.log(a) - jnp.log1p(-a)
    inp['lru_w_out'] = nrm((nB, LRU_WIDTH, D), LRU_WIDTH ** -0.5)
    inp['hyena_w_in'] = nrm((nC, D, 3 * HYENA_WIDTH), D ** -0.5)
    inp['hyena_conv_w'] = nrm((nC, HYENA_CONV, 3 * HYENA_WIDTH), HYENA_CONV ** -0.5)
    inp['hyena_conv_b'] = nrm((nC, 3 * HYENA_WIDTH), 0.02)
    inp['hyena_f_w1'] = nrm((nC, HYENA_EMB, HYENA_FILTER_HIDDEN), HYENA_EMB ** -0.5)
    inp['hyena_f_b1'] = nrm((nC, HYENA_FILTER_HIDDEN), 0.02)
    inp['hyena_f_w2'] = nrm((nC, HYENA_FILTER_HIDDEN, HYENA_FILTER_HIDDEN), HYENA_FILTER_HIDDEN ** -0.5)
    inp['hyena_f_b2'] = nrm((nC, HYENA_FILTER_HIDDEN), 0.02)
    inp['hyena_f_w3'] = nrm((nC, HYENA_FILTER_HIDDEN, HYENA_FILTER_HIDDEN), HYENA_FILTER_HIDDEN ** -0.5)
    inp['hyena_f_b3'] = nrm((nC, HYENA_FILTER_HIDDEN), 0.02)
    inp['hyena_f_freq'] = 1.0 + nrm((nC, 3, HYENA_FILTER_HIDDEN), 0.05)
    inp['hyena_f_wout'] = nrm((nC, HYENA_FILTER_HIDDEN, HYENA_ORDER * 2 * HYENA_WIDTH), 0.1 * HYENA_FILTER_HIDDEN ** -0.5)
    inp['hyena_bias'] = nrm((nC, HYENA_ORDER, HYENA_WIDTH), 0.1)
    inp['hyena_w_out'] = nrm((nC, HYENA_WIDTH, D), HYENA_WIDTH ** -0.5)
    inp['pool_w_in'] = nrm((nD, D, POOL_WIDTH), D ** -0.5)
    inp['pool_w_g'] = nrm((nD, len(POOL_WINDOWS), POOL_GROUP, POOL_GROUP), POOL_GROUP ** -0.5)
    inp['pool_b_g'] = nrm((nD, len(POOL_WINDOWS), POOL_GROUP), 0.02)
    inp['pool_scale'] = 1.0 + nrm((nD, POOL_WIDTH), 0.05)
    inp['pool_w_out'] = nrm((nD, POOL_WIDTH, D), POOL_WIDTH ** -0.5)
    inp['ffn_w_gate'] = nrm((nF, D, D_FF), D ** -0.5)
    inp['ffn_w_up'] = nrm((nF, D, D_FF), D ** -0.5)
    inp['ffn_w_down'] = nrm((nF, D_FF, D), D_FF ** -0.5)
    inp['moe_w_router'] = nrm((nM, D, N_EXPERTS), D ** -0.5)
    inp['moe_w_gate'] = nrm((nM, N_EXPERTS, D, EXPERT_FF), D ** -0.5)
    inp['moe_w_up'] = nrm((nM, N_EXPERTS, D, EXPERT_FF), D ** -0.5)
    inp['moe_w_down'] = nrm((nM, N_EXPERTS, EXPERT_FF, D), EXPERT_FF ** -0.5)
    return inp


def reference(x, c, ctx, c_ctx, ada_w, ada_b, norm_g,
              gmlp_w_in, gmlp_g_v, gmlp_w_s, gmlp_b_s, gmlp_w_out,
              lru_w_in, lru_conv_w, lru_conv_b, lru_w_a, lru_b_a, lru_w_x, lru_b_x, lru_lam, lru_w_out,
              hyena_w_in, hyena_conv_w, hyena_conv_b, hyena_f_w1, hyena_f_b1, hyena_f_w2, hyena_f_b2,
              hyena_f_w3, hyena_f_b3, hyena_f_freq, hyena_f_wout, hyena_bias, hyena_w_out,
              pool_w_in, pool_w_g, pool_b_g, pool_scale, pool_w_out,
              ffn_w_gate, ffn_w_up, ffn_w_down,
              moe_w_router, moe_w_gate, moe_w_up, moe_w_down):
    B, L, _ = x.shape
    rows = L // GRID_W
    x = x + grid_pos_embed(rows, x.dtype)[None]
    xc = ctx
    last_ctx = max([i for i in range(DEPTH) if i % N_MIXERS == 1], default=-1)

    for i in range(DEPTH):
        kind, j = i % N_MIXERS, i // N_MIXERS
        update_ctx = i < last_ctx
        read_ctx = i <= last_ctx
        sh1, sc1, gt1, sh2, sc2, gt2 = jnp.split((jax.nn.silu(c) @ ada_w[i] + ada_b[i])[:, None, :], 6, axis=-1)
        h = modulate(rmsnorm(x, norm_g[i, 0]), sh1, sc1)
        hc = None
        if read_ctx:
            csh1, csc1, cgt1, csh2, csc2, cgt2 = jnp.split(jax.nn.silu(c_ctx) @ ada_w[i] + ada_b[i], 6, axis=-1)
            hc = modulate(rmsnorm(xc, norm_g[i, 0]), csh1, csc1)

        y_c = None
        if kind == 0:
            p = (gmlp_w_in[j], gmlp_g_v[j], gmlp_w_s[j], gmlp_b_s[j], gmlp_w_out[j])
            y = gmlp_mixer(h, *p)
            if update_ctx:
                y_c = gmlp_mixer(hc, *p)
        elif kind == 1:
            y, y_c = lru_mixer(h, hc, lru_w_in[j], lru_conv_w[j], lru_conv_b[j], lru_w_a[j], lru_b_a[j],
                               lru_w_x[j], lru_b_x[j], lru_lam[j], lru_w_out[j], update_ctx)
        elif kind == 2:
            p = (hyena_w_in[j], hyena_conv_w[j], hyena_conv_b[j], hyena_f_w1[j], hyena_f_b1[j],
                 hyena_f_w2[j], hyena_f_b2[j], hyena_f_w3[j], hyena_f_b3[j], hyena_f_freq[j],
                 hyena_f_wout[j], hyena_bias[j], hyena_w_out[j])
            y = hyena_mixer(h, *p)
            if update_ctx:
                y_c = hyena_mixer(hc, *p)
        else:
            p = (pool_w_in[j], pool_w_g[j], pool_b_g[j], pool_scale[j], pool_w_out[j])
            y = pool_mixer(h, *p)
            if update_ctx:
                y_c = pool_mixer(hc, *p)

        x = x + gt1 * rmsnorm(y, norm_g[i, 1])
        if update_ctx:
            xc = xc + cgt1 * rmsnorm(y_c, norm_g[i, 1])

        k = i // 2

        def channel_mixer(t):
            if i % 2 == 0:
                return swiglu(t, ffn_w_gate[k], ffn_w_up[k], ffn_w_down[k])
            return moe_ffn(t, moe_w_router[k], moe_w_gate[k], moe_w_up[k], moe_w_down[k])

        x = x + gt2 * rmsnorm(channel_mixer(modulate(rmsnorm(x, norm_g[i, 2]), sh2, sc2)), norm_g[i, 3])
        if update_ctx:
            xc = xc + cgt2 * rmsnorm(channel_mixer(modulate(rmsnorm(xc, norm_g[i, 2]), csh2, csc2)), norm_g[i, 3])
    return x
```

```cpp
#define STOP_AFTER 99
#define FFN8_MASK 3
#include <hip/hip_runtime.h>
#include <math.h>
#include <stdio.h>

#define LAS __attribute__((address_space(3)))
typedef unsigned short bf16_t;
typedef short bf16x8 __attribute__((ext_vector_type(8)));
typedef float f32x4 __attribute__((ext_vector_type(4)));
typedef float f32x2 __attribute__((ext_vector_type(2)));
typedef float f32x16 __attribute__((ext_vector_type(16)));
typedef unsigned u32x4 __attribute__((ext_vector_type(4)));
typedef unsigned u32x2 __attribute__((ext_vector_type(2)));

constexpr int D = 1024, SEQ = 16384, ML = 32768, CTXL = 256, MC = 512, MT = ML + MC;
constexpr int GW = 2048;
constexpr int DFF = 2816, EFF = 3584, NEXP = 8;
constexpr float EPS = 1e-6f;
constexpr int NWAVES = 8, NTHR = 512;
constexpr int MOE_MAXT = 264;
constexpr int MOE_CHUNK = 132;

constexpr size_t MiB = (size_t)1 << 20;
constexpr size_t WS_CTL = 0, CTL_ZERO_BYTES = 32 * 1024;
constexpr size_t WS_MOD = 1 * MiB;
constexpr size_t WS_PE = 2 * MiB;
constexpr size_t WS_XC = 3 * MiB;
constexpr size_t WS_ROUTE = 5 * MiB;
constexpr size_t WS_ROWSTAT = 6 * MiB;
constexpr size_t WS_COUNTS = 7 * MiB;
constexpr size_t WS_AGG = 8 * MiB;
constexpr size_t WS_CARRY = 17 * MiB;
constexpr size_t WS_WS16 = 21 * MiB;
constexpr size_t WS_LRUW = 21 * MiB + 512 * 1024;
constexpr size_t WS_POOLW = 22 * MiB + 512 * 1024;
constexpr size_t WS_HYW = 23 * MiB;
constexpr size_t WS_HQ = 24 * MiB;
constexpr size_t WS_W = 40 * MiB;
constexpr size_t W_GIN = WS_W, W_GOUT = W_GIN + 8 * MiB, W_LIN = W_GOUT + 4 * MiB, W_LOUT = W_LIN + 4 * MiB, W_HIN = W_LOUT + 2 * MiB, W_HOUT = W_HIN + 6 * MiB,
                 W_PIN = W_HOUT + 2 * MiB, W_POUT = W_PIN + 2 * MiB, W_FGU = W_POUT + 2 * MiB  , W_FD = W_FGU + 22 * MiB  , W_END = W_FD + 11 * MiB;
static_assert(W_END <= 104 * MiB, "weights");
constexpr size_t WS_WMOE = 104 * MiB;
constexpr size_t WM_GU = WS_WMOE, WM_D = WS_WMOE + 112 * MiB;
constexpr size_t WS_H = 272 * MiB;
constexpr size_t WS_Y = 337 * MiB;
constexpr size_t WS_BIG = 469 * MiB;
constexpr size_t WS_XB = 859 * MiB;
constexpr size_t WS_END = 923 * MiB;
constexpr int CW_BAR = 4096;

typedef __bf16 bf16x2v __attribute__((ext_vector_type(2)));
__device__ __forceinline__ unsigned pk2(float lo, float hi) { const f32x2 f = {lo, hi}; const bf16x2v b = __builtin_convertvector(f, bf16x2v); return __builtin_bit_cast(unsigned, b); }
__device__ __forceinline__ unsigned f2bf(float f) { return pk2(f, 0.0f) & 0xffffu; }
__device__ __forceinline__ float bflo(unsigned w) { return __builtin_bit_cast(float, w << 16); }
__device__ __forceinline__ float bfhi(unsigned w) { return __builtin_bit_cast(float, w & 0xffff0000u); }
__device__ __forceinline__ float bf1(bf16_t h) { return __builtin_bit_cast(float, ((unsigned)h) << 16); }
__device__ __forceinline__ float wave_sum(float v) {
#define WS_DPP(ctrl_, rmask_) v += __builtin_bit_cast(float, __builtin_amdgcn_update_dpp(0, __builtin_bit_cast(int, v), (ctrl_), (rmask_), 0xf, false))
    WS_DPP(0xB1, 0xf);
    WS_DPP(0x4E, 0xf);
    WS_DPP(0x141, 0xf);
    WS_DPP(0x140, 0xf);
    WS_DPP(0x142, 0xa);
    WS_DPP(0x143, 0xc);
#undef WS_DPP
    return __builtin_bit_cast(float, __builtin_amdgcn_readlane(__builtin_bit_cast(int, v), 63));
}
__device__ __forceinline__ float fexp_(float x) { return __builtin_amdgcn_exp2f(x * 1.4426950408889634f); }
__device__ __forceinline__ float sigmoidf_(float x) { return __builtin_amdgcn_rcpf(1.0f + fexp_(-x)); }
__device__ __forceinline__ float siluf_(float x) { return x * __builtin_amdgcn_rcpf(1.0f + fexp_(-x)); }
__device__ __forceinline__ float gelu_tanh(float x) { const float u = -2.302208198f * (x + 0.044715f * x * x * x); return x * __builtin_amdgcn_rcpf(1.0f + __builtin_amdgcn_exp2f(u)); }
typedef int i32x4 __attribute__((ext_vector_type(4)));
typedef int i32x8 __attribute__((ext_vector_type(8)));
__device__ __forceinline__ float clamp448(float x) { return __builtin_fminf(__builtin_fmaxf(x, -448.0f), 448.0f); }
__device__ __forceinline__ unsigned pk4_fp8(float a, float b, float c, float d) {
    int r = 0; r = __builtin_amdgcn_cvt_pk_fp8_f32(clamp448(a), clamp448(b), r, false); r = __builtin_amdgcn_cvt_pk_fp8_f32(clamp448(c), clamp448(d), r, true); return (unsigned)r; }
#define LDS_WAIT() asm volatile("s_waitcnt lgkmcnt(0)" ::: "memory")
#define VM_WAIT() asm volatile("s_waitcnt vmcnt(0)" ::: "memory")
#define XB_TMO      128
#define XB_XCNT(j)  (256  + 64 * (j))
#define XB_XSUB(j)  (1280 + 64 * (j))
#define XB_XGEN(j)  (2304 + 64 * (j))
#define XB_TOP      3328
#define XB_TOPGEN   3392
#define XCD_BAR_WORDS 3456
#define XB_SPIN_CAP (1u << 18)
__device__ __forceinline__ unsigned xb_ld(unsigned* p)              { return __hip_atomic_load(p, __ATOMIC_RELAXED, __HIP_MEMORY_SCOPE_AGENT); }
__device__ __forceinline__ unsigned xb_add(unsigned* p, unsigned v) { return __hip_atomic_fetch_add(p, v, __ATOMIC_RELAXED, __HIP_MEMORY_SCOPE_AGENT); }
__device__ __forceinline__ unsigned xb_xcc_id() { return (unsigned)__builtin_amdgcn_s_getreg((3 << 11) | 20) & 0xFu; }
#define XB_SPIN(cond, bar) do { unsigned _sp = 0; while (cond) { __builtin_amdgcn_s_sleep(1); \
    if ((++_sp & 255u) == 0u) { if (xb_ld(&(bar)[XB_TMO])) break; if (_sp > XB_SPIN_CAP) { atomicAdd(&(bar)[XB_TMO], 1u); break; } } } } while (0)

__device__ __forceinline__ int lane_now() { int l; asm volatile("v_mbcnt_lo_u32_b32 %0, -1, 0\n\tv_mbcnt_hi_u32_b32 %0, -1, %0" : "=v"(l)); return l; }
struct XcdBarrier {
    unsigned* bar; unsigned x;
    int w;
    volatile LAS unsigned* st;
};

__device__ __forceinline__ XcdBarrier xcd_barrier_post(unsigned* bar, volatile LAS unsigned* st) {
    XcdBarrier b; b.bar = bar; b.x = xb_xcc_id(); b.st = st; b.w = 0;
    if (threadIdx.x == 0) (void)xb_add(&bar[XB_XCNT(b.x)], 1u);
    return b;
}
__device__ __forceinline__ void xcd_barrier_complete(unsigned* bar, unsigned x, unsigned& nloc, unsigned& nx) {
    const unsigned G = gridDim.x * gridDim.y * gridDim.z;
    unsigned sum, cnt, mine, sp = 0u;
    for (;;) {
        sum = 0u; cnt = 0u; mine = 0u;
#pragma unroll
        for (unsigned j = 0; j < 16; ++j) { const unsigned c = xb_ld(&bar[XB_XCNT(j)]); sum += c; cnt += (c > 0u) ? 1u : 0u; mine = (j == x) ? c : mine; }
        if (sum == G) break;
        __builtin_amdgcn_s_sleep(1);
        if ((++sp & 255u) == 0u) { if (xb_ld(&bar[XB_TMO])) break; if (sp > XB_SPIN_CAP) { atomicAdd(&bar[XB_TMO], 1u); break; } }
    }
    nloc = mine > 0u ? mine : 1u; nx = cnt > 0u ? cnt : 1u;
}

__device__ __forceinline__ void xcd_barrier(const XcdBarrier& b) {
    asm volatile("s_waitcnt vmcnt(0)" ::: "memory");
    __syncthreads();
    if (b.w == 0 && lane_now() == 0) {
        unsigned* bar = b.bar;
        __builtin_amdgcn_s_waitcnt(0);
        unsigned nloc = b.st[0], nx = b.st[1];
        if (nloc == 0u) { xcd_barrier_complete(bar, b.x, nloc, nx); b.st[0] = nloc; b.st[1] = nx; }
        const unsigned old = xb_add(&bar[XB_XSUB(b.x)], 1u);
        const unsigned gen = old / nloc;
        if (old + 1u == (gen + 1u) * nloc) {
            __builtin_amdgcn_fence(__ATOMIC_RELEASE, "agent");
            asm volatile("s_waitcnt vmcnt(0)" ::: "memory");
            const unsigned og = xb_add(&bar[XB_TOP], 1u);
            const unsigned tg = og / nx;
            if (og + 1u == (tg + 1u) * nx) xb_add(&bar[XB_TOPGEN], 1u);
            else XB_SPIN(xb_ld(&bar[XB_TOPGEN]) == tg, bar);
            __builtin_amdgcn_fence(__ATOMIC_ACQUIRE, "agent");
            xb_add(&bar[XB_XGEN(b.x)], 1u);
            asm volatile("s_waitcnt vmcnt(0)" ::: "memory");
        } else {
            XB_SPIN(xb_ld(&bar[XB_XGEN(b.x)]) == gen, bar);
            __builtin_amdgcn_fence(__ATOMIC_ACQUIRE, "agent");
            asm volatile("s_waitcnt vmcnt(0)" ::: "memory");
        }
    }
    __syncthreads();
}
namespace pg8 {
constexpr int BM = 256, BK = 64, HALF = 128, HTB = HALF * BK * 2, STAGE_BYTES = 8 * HTB, NXCD = 8, WGM = 8;
__host__ __device__ __forceinline__ int lds_byte(int r, int c) { const int st = (r >> 4) * 2 + (c >> 5), rr = r & 15, cc = c & 31, ob = rr * 64 + cc * 2; return st * 1024 + (ob ^ (((ob >> 9) & 1) << 5)); }
__host__ __device__ __forceinline__ void stage_rc(int b, int& R, int& C) { const int st = b / 1024, sb = b % 1024, swz = sb ^ (((sb >> 9) & 1) << 5); R = (st >> 1) * 16 + swz / 64; C = (st & 1) * 32 + (swz % 64) / 2; }
__host__ __device__ __forceinline__ int perm32(int rho) { const int n = rho >> 4, i = rho & 15; return 8 * (i >> 2) + 4 * n + (i & 3); }

struct Unit { int pm, pn; };

struct Sched {
    int nM, nN, nwg, G, c, pm0; const char* A; const char* Bt; size_t a_tstep, b_tstep, b_estride; const LAS int* tile_exp;
    __device__ __forceinline__ void init(const void* A_, const void* Bt_, int nM_, int nN_, int K, int G_, int c_, int eb = 2) {
        nM = nM_; nN = nN_; nwg = nM * nN; G = G_; c = c_; pm0 = 0; A = (const char*)A_; Bt = (const char*)Bt_; a_tstep = (size_t)BM * K * eb; b_tstep = a_tstep; b_estride = 0; tile_exp = nullptr; }
    __device__ __forceinline__ bool next(int i, Unit& u) const {
        const long L = (long)i * G + c; if (L >= nwg) return false;
        int wgid = (int)L; { const int q = nwg / NXCD, r = nwg % NXCD, xcd = wgid % NXCD, off = wgid / NXCD; wgid = (xcd < r ? xcd * (q + 1) : r * (q + 1) + (xcd - r) * q) + off; }
        const int nig = WGM * nN, gid = wgid / nig, fm = gid * WGM, gsz = (nM - fm) < WGM ? (nM - fm) : WGM;
        u.pm = pm0 + fm + ((wgid % nig) % gsz); u.pn = (wgid % nig) / gsz; return true;
    }
    __device__ __forceinline__ const char* aptr(const Unit& u) const { return A + (size_t)(u.pm - pm0) * a_tstep; }
    __device__ __forceinline__ const char* bptr(const Unit& u) const { return Bt + (tile_exp ? (size_t)tile_exp[u.pm] * b_estride : (size_t)0) + (size_t)u.pn * b_tstep; }
};

__device__ __forceinline__ unsigned cvt_pk_bf16(float lo, float hi) { unsigned r; asm volatile("v_cvt_pk_bf16_f32 %0, %1, %2" : "=v"(r) : "v"(lo), "v"(hi)); return r; }

struct EpiAct {
    static constexpr bool PERM = true;
    bf16_t* O; int ldc; int gelu_cols;
    __device__ __forceinline__ void operator()(const f32x4 (&acc)[2][2][4][2], const Unit& u, int wr, int wc, int fr, int fq) const {
        const int row0 = u.pm * BM + wr * 64 + fr; const int col0 = u.pn * BM + wc * 32 + 8 * fq; const bool act = (u.pn * BM) < gelu_cols;
#pragma unroll
        for (int ai = 0; ai < 2; ++ai)
#pragma unroll
            for (int m = 0; m < 4; ++m) { bf16_t* rowp = O + (size_t)(row0 + ai * HALF + m * 16) * ldc + col0;
#pragma unroll
                for (int bj = 0; bj < 2; ++bj) { f32x4 v0 = acc[ai][bj][m][0], v1 = acc[ai][bj][m][1];
                    if (act) {
#pragma unroll
                        for (int j = 0; j < 4; ++j) { v0[j] = gelu_tanh(v0[j]); v1[j] = gelu_tanh(v1[j]); } }
                    u32x4 w; w.x = cvt_pk_bf16(v0[0], v0[1]); w.y = cvt_pk_bf16(v0[2], v0[3]); w.z = cvt_pk_bf16(v1[0], v1[1]); w.w = cvt_pk_bf16(v1[2], v1[3]);
                    *(u32x4*)(rowp + bj * HALF) = w; } }
    }
};
struct EpiActS {
    static constexpr bool PERM = true;
    bf16_t* O; int ldc; int gelu_cols; float gscale;
    __device__ __forceinline__ void operator()(const f32x4 (&acc)[2][2][4][2], const Unit& u, int wr, int wc, int fr, int fq) const {
        const int row0 = u.pm * BM + wr * 64 + fr; const int col0 = u.pn * BM + wc * 32 + 8 * fq; const bool act = (u.pn * BM) < gelu_cols;
#pragma unroll
        for (int ai = 0; ai < 2; ++ai)
#pragma unroll
            for (int m = 0; m < 4; ++m) { bf16_t* rowp = O + (size_t)(row0 + ai * HALF + m * 16) * ldc + col0;
#pragma unroll
                for (int bj = 0; bj < 2; ++bj) { f32x4 v0 = acc[ai][bj][m][0], v1 = acc[ai][bj][m][1];
                    if (act) {
#pragma unroll
                        for (int j = 0; j < 4; ++j) { v0[j] = gelu_tanh(v0[j] * gscale); v1[j] = gelu_tanh(v1[j] * gscale); } }
                    u32x4 w; w.x = cvt_pk_bf16(v0[0], v0[1]); w.y = cvt_pk_bf16(v0[2], v0[3]); w.z = cvt_pk_bf16(v1[0], v1[1]); w.w = cvt_pk_bf16(v1[2], v1[3]);
                    *(u32x4*)(rowp + bj * HALF) = w; } }
    }
};
struct EpiGeluStats {
    static constexpr bool PERM = true;
    bf16_t* O; int ldc; f32x2* part;
    __device__ __forceinline__ void operator()(const f32x4 (&acc)[2][2][4][2], const Unit& u, int wr, int wc, int fr, int fq) const {
        const int row0 = u.pm * BM + wr * 64 + fr; const int col0 = u.pn * BM + wc * 32 + 8 * fq; const bool isv = u.pn >= 8;
#pragma unroll
        for (int ai = 0; ai < 2; ++ai)
#pragma unroll
            for (int m = 0; m < 4; ++m) { const int row = row0 + ai * HALF + m * 16; bf16_t* rowp = O + (size_t)row * ldc + col0; float s = 0.f, q = 0.f;
#pragma unroll
                for (int bj = 0; bj < 2; ++bj) { f32x4 v0 = acc[ai][bj][m][0], v1 = acc[ai][bj][m][1];
#pragma unroll
                    for (int j = 0; j < 4; ++j) { v0[j] = gelu_tanh(v0[j]); v1[j] = gelu_tanh(v1[j]); s += v0[j] + v1[j]; q += v0[j] * v0[j] + v1[j] * v1[j]; }
                    u32x4 w; w.x = cvt_pk_bf16(v0[0], v0[1]); w.y = cvt_pk_bf16(v0[2], v0[3]); w.z = cvt_pk_bf16(v1[0], v1[1]); w.w = cvt_pk_bf16(v1[2], v1[3]);
                    *(u32x4*)(rowp + bj * HALF) = w; }
                if (isv) { s += __shfl_xor(s, 16); q += __shfl_xor(q, 16); s += __shfl_xor(s, 32); q += __shfl_xor(q, 32);
                    if (fq == 0) part[(size_t)row * 32 + (u.pn - 8) * 4 + wc] = (f32x2){s, q}; } }
    }
};
struct EpiSwiGLU {
    static constexpr bool PERM = true;
    bf16_t* O; int ldc; int pm_sub;
    __device__ __forceinline__ void operator()(const f32x4 (&acc)[2][2][4][2], const Unit& u, int wr, int wc, int fr, int fq) const {
        const int row0 = (u.pm - pm_sub) * BM + wr * 64 + fr; const int col0 = u.pn * HALF + wc * 32 + 8 * fq;
#pragma unroll
        for (int ai = 0; ai < 2; ++ai)
#pragma unroll
            for (int m = 0; m < 4; ++m) { bf16_t* rowp = O + (size_t)(row0 + ai * HALF + m * 16) * ldc + col0;
                f32x4 g0 = acc[ai][0][m][0], g1 = acc[ai][0][m][1]; const f32x4 u0 = acc[ai][1][m][0], u1 = acc[ai][1][m][1];
#pragma unroll
                for (int j = 0; j < 4; ++j) { g0[j] = siluf_(g0[j]) * u0[j]; g1[j] = siluf_(g1[j]) * u1[j]; }
                u32x4 w; w.x = cvt_pk_bf16(g0[0], g0[1]); w.y = cvt_pk_bf16(g0[2], g0[3]); w.z = cvt_pk_bf16(g1[0], g1[1]); w.w = cvt_pk_bf16(g1[2], g1[3]);
                *(u32x4*)rowp = w; }
    }
};
struct EpiSwiGLU8 {
    static constexpr bool PERM = true;
    unsigned char* O; int ldc; int pm_sub; float oscale, iscale; int dry;
    __device__ __forceinline__ void operator()(const f32x4 (&acc)[2][2][4][2], const Unit& u, int wr, int wc, int fr, int fq) const {
        if (dry) return;
        const int row0 = (u.pm - pm_sub) * BM + wr * 64 + fr; const int col0 = u.pn * HALF + wc * 32 + 8 * fq;
        const float kexp = -1.4426950408889634f * iscale, cinv = 1.0f / (iscale * iscale * oscale);
#pragma unroll
        for (int ai = 0; ai < 2; ++ai)
#pragma unroll
            for (int m = 0; m < 4; ++m) { unsigned char* rowp = O + (size_t)(row0 + ai * HALF + m * 16) * ldc + col0;
                f32x4 g0 = acc[ai][0][m][0], g1 = acc[ai][0][m][1]; const f32x4 u0 = acc[ai][1][m][0], u1 = acc[ai][1][m][1];
#pragma unroll
                for (int j = 0; j < 4; ++j) { g0[j] = (g0[j] * u0[j]) * __builtin_amdgcn_rcpf(__builtin_fmaf(__builtin_amdgcn_exp2f(g0[j] * kexp), cinv, cinv)); g1[j] = (g1[j] * u1[j]) * __builtin_amdgcn_rcpf(__builtin_fmaf(__builtin_amdgcn_exp2f(g1[j] * kexp), cinv, cinv)); }
                u32x2 w; w.x = pk4_fp8(g0[0], g0[1], g0[2], g0[3]); w.y = pk4_fp8(g1[0], g1[1], g1[2], g1[3]);
                *(u32x2*)rowp = w; }
    }
};
struct EpiFilt {
    static constexpr bool PERM = true;
    bf16_t* O;
    __device__ __forceinline__ void operator()(const f32x4 (&acc)[2][2][4][2], const Unit& u, int wr, int wc, int fr, int fq) const {
        const int row0 = u.pm * BM + wr * 64 + fr; const int col0 = u.pn * BM + wc * 32 + 8 * fq;
#pragma unroll
        for (int ai = 0; ai < 2; ++ai)
#pragma unroll
            for (int m = 0; m < 4; ++m) { const int row = row0 + ai * HALF + m * 16; const int ch = row & 1023;
                const float dl = (3.0701134573253945f + 12.280453829301578f * ((float)ch * (1.0f / 1023.0f))) * (1.4426950408889634f / 16383.0f);
                bf16_t* rowp = O + (size_t)row * 32768 + col0;
#pragma unroll
                for (int bj = 0; bj < 2; ++bj) { const int q = col0 + bj * HALF; const int n0 = q >> 10, n1 = (q >> 5) & 31, n2 = q & 31;
                    const int nn = n0 + 32 * n1 + 1024 * n2; const bool fwd = nn < 16384; const int t0 = fwd ? nn : 32768 - nn;
                    float wv = exp2f(-(float)t0 * dl); const float rr = exp2f(fwd ? -1024.0f * dl : 1024.0f * dl);
                    const f32x4 v0 = acc[ai][bj][m][0], v1 = acc[ai][bj][m][1]; float o[8];
#pragma unroll
                    for (int j = 0; j < 8; ++j) { o[j] = (j < 4 ? v0[j & 3] : v1[j & 3]) * wv; wv *= rr; }
                    u32x4 w; w.x = cvt_pk_bf16(o[0], o[1]); w.y = cvt_pk_bf16(o[2], o[3]); w.z = cvt_pk_bf16(o[4], o[5]); w.w = cvt_pk_bf16(o[6], o[7]);
                    *(u32x4*)(rowp + bj * HALF) = w; } }
    }
};

template <int EB> struct Frag { typedef bf16x8 A[4][2]; typedef bf16x8 B[2][2]; };
template <> struct Frag<1> { typedef i32x8 A[4]; typedef i32x8 B[2]; };
template <class Epi, int EB = 2>
__device__ __forceinline__ void gemm_phase(LAS unsigned char* lds, const int K, const Sched& S, const Epi& E, const int wave) {
    const int tid_ = wave * 64 + lane_now();
    const int tid = tid_, wid = wave, lane = tid & 63, wr = wid >> 2, wc = wid & 3, fr = lane & 15, fq = lane >> 4;
    const int KB = K * EB;
    const int nt = KB / 128;
    unsigned voffA[2], voffB[2];
#pragma unroll
    for (int i = 0; i < 2; ++i) { int R, C; stage_rc(tid * 16 + i * 8192, R, C); const int Rb = Epi::PERM ? ((R & ~31) + perm32(R & 31)) : R;
        voffA[i] = (unsigned)(R * KB + C * 2); voffB[i] = (unsigned)(Rb * KB + C * 2); }
    const size_t kstep = (size_t)128;
    const size_t hstep = (size_t)HALF * KB;
    const unsigned ldsw = (unsigned)wid * 1024u;
    const int aoff = lds_byte(wr * 64 + fr, fq * 8), boff = lds_byte(wc * 32 + fr, fq * 8);
#define PG8_SA(b, h) (((b) * 2 + (h)) * HTB)
#define PG8_SB(b, h) ((4 + (b) * 2 + (h)) * HTB)
#define PG8_STAGE(bufoff, gbase, voff) do { _Pragma("unroll") for (int _i = 0; _i < 2; ++_i) \
        __builtin_amdgcn_global_load_lds((const unsigned*)((const char*)(gbase) + (voff)[_i]), (LAS unsigned*)(lds + (bufoff) + ldsw + _i * 8192), 16, 0, 0); } while (0)
#define PG8_LDA(dst, b, h) do { if constexpr (EB == 2) { _Pragma("unroll") for (int m = 0; m < 4; ++m) _Pragma("unroll") for (int k = 0; k < 2; ++k) dst[m][k] = *(const LAS bf16x8*)(lds + PG8_SA(b, h) + aoff + m * 2048 + k * 1024); } \
        else { _Pragma("unroll") for (int m = 0; m < 4; ++m) dst[m] = PG8_CAT8(*(const LAS i32x4*)(lds + PG8_SA(b, h) + aoff + m * 2048), *(const LAS i32x4*)(lds + PG8_SA(b, h) + aoff + m * 2048 + 1024)); } } while (0)
#define PG8_LDB(dst, b, h) do { if constexpr (EB == 2) { _Pragma("unroll") for (int n = 0; n < 2; ++n) _Pragma("unroll") for (int k = 0; k < 2; ++k) dst[n][k] = *(const LAS bf16x8*)(lds + PG8_SB(b, h) + boff + n * 2048 + k * 1024); } \
        else { _Pragma("unroll") for (int n = 0; n < 2; ++n) dst[n] = PG8_CAT8(*(const LAS i32x4*)(lds + PG8_SB(b, h) + boff + n * 2048), *(const LAS i32x4*)(lds + PG8_SB(b, h) + boff + n * 2048 + 1024)); } } while (0)
#define PG8_CAT8(x, y) __builtin_shufflevector(__builtin_bit_cast(i32x4, (x)), __builtin_bit_cast(i32x4, (y)), 0, 1, 2, 3, 4, 5, 6, 7)
#define PG8_MMA(ai, bj, At, Bt) do { __builtin_amdgcn_s_setprio(1); \
        if constexpr (EB == 2) { _Pragma("unroll") for (int m = 0; m < 4; ++m) _Pragma("unroll") for (int n = 0; n < 2; ++n) _Pragma("unroll") for (int k = 0; k < 2; ++k) \
            acc[ai][bj][m][n] = __builtin_amdgcn_mfma_f32_16x16x32_bf16(Bt[n][k], At[m][k], acc[ai][bj][m][n], 0, 0, 0); } \
        else { _Pragma("unroll") for (int m = 0; m < 4; ++m) _Pragma("unroll") for (int n = 0; n < 2; ++n) \
            asm volatile("v_mfma_f32_16x16x128_f8f6f4 %0, %1, %2, %0" : "+v"(acc[ai][bj][m][n]) : "v"(Bt[n]), "v"(At[m])); } \
        __builtin_amdgcn_s_setprio(0); } while (0)
#define PG8_WAIT_V(n) asm volatile("s_waitcnt vmcnt(" #n ")" ::: "memory")
#define PG8_WAIT_L(n) asm volatile("s_waitcnt lgkmcnt(" #n ")" ::: "memory")
#define PG8_BAR __builtin_amdgcn_s_barrier()
#define PG8_SCHED __builtin_amdgcn_sched_barrier(0)
#define PG8_SCHED8 do { if constexpr (EB == 1) __builtin_amdgcn_sched_barrier(0); } while (0)
    Unit cur, nxt; int ui = 0;
    if (!S.next(0, cur)) return;
    f32x4 acc[2][2][4][2];
#pragma unroll
    for (int a = 0; a < 2; ++a)
#pragma unroll
        for (int b = 0; b < 2; ++b)
#pragma unroll
            for (int m = 0; m < 4; ++m)
#pragma unroll
                for (int n = 0; n < 2; ++n) acc[a][b][m][n] = (f32x4){0.f, 0.f, 0.f, 0.f};
    typename Frag<EB>::A At; typename Frag<EB>::B B0, B1;
    const char* cA = S.aptr(cur); const char* cB = S.bptr(cur);
    PG8_STAGE(PG8_SB(0, 0), cB, voffB); PG8_STAGE(PG8_SA(0, 0), cA, voffA); PG8_STAGE(PG8_SB(0, 1), cB + hstep, voffB); PG8_STAGE(PG8_SA(0, 1), cA + hstep, voffA);
    if (wr == 1) PG8_BAR;
    PG8_WAIT_V(4); PG8_BAR;
    PG8_STAGE(PG8_SB(1, 0), cB + kstep, voffB); PG8_STAGE(PG8_SA(1, 0), cA + kstep, voffA); PG8_STAGE(PG8_SB(1, 1), cB + hstep + kstep, voffB);
    PG8_WAIT_V(6); PG8_BAR;
    for (;;) {
        const bool has_next = S.next(ui + 1, nxt);
        const char* nA = has_next ? S.aptr(nxt) : cA; const char* nB = has_next ? S.bptr(nxt) : cB;
        for (int t = 0; t < nt; t += 2) {
            const bool last = (t == nt - 2);
            const char* a1 = cA + (size_t)(t + 1) * kstep;
            const char* a2 = last ? nA : cA + (size_t)(t + 2) * kstep; const char* b2 = last ? nB : cB + (size_t)(t + 2) * kstep;
            const char* a3 = a2 + kstep; const char* b3 = b2 + kstep;
            PG8_LDB(B0, 0, 0); PG8_SCHED; PG8_LDA(At, 0, 0); PG8_STAGE(PG8_SA(1, 1), a1 + hstep, voffA);
            PG8_WAIT_L(8); PG8_BAR; PG8_WAIT_L(0); PG8_MMA(0, 0, At, B0); PG8_BAR; PG8_SCHED;
            PG8_LDB(B1, 0, 1); PG8_STAGE(PG8_SB(0, 0), b2, voffB);
            PG8_BAR; PG8_WAIT_L(0); PG8_MMA(0, 1, At, B1); PG8_BAR; PG8_SCHED8;
            PG8_LDA(At, 0, 1); PG8_STAGE(PG8_SA(0, 0), a2, voffA);
            PG8_BAR; PG8_WAIT_L(0); PG8_MMA(1, 0, At, B0); PG8_BAR; PG8_SCHED;
            PG8_STAGE(PG8_SB(0, 1), b2 + hstep, voffB);
            PG8_WAIT_V(6); PG8_BAR; PG8_MMA(1, 1, At, B1); PG8_BAR; PG8_SCHED8;
            PG8_LDB(B0, 1, 0); PG8_SCHED; PG8_LDA(At, 1, 0); PG8_STAGE(PG8_SA(0, 1), a2 + hstep, voffA);
            PG8_WAIT_L(8); PG8_BAR; PG8_WAIT_L(0); PG8_MMA(0, 0, At, B0); PG8_BAR; PG8_SCHED;
            PG8_LDB(B1, 1, 1); PG8_STAGE(PG8_SB(1, 0), b3, voffB);
            PG8_BAR; PG8_WAIT_L(0); PG8_MMA(0, 1, At, B1); PG8_BAR; PG8_SCHED8;
            PG8_LDA(At, 1, 1); PG8_STAGE(PG8_SA(1, 0), a3, voffA);
            PG8_BAR; PG8_WAIT_L(0); PG8_MMA(1, 0, At, B0); PG8_BAR; PG8_SCHED;
            PG8_STAGE(PG8_SB(1, 1), b3 + hstep, voffB);
            PG8_WAIT_V(6); PG8_BAR; PG8_MMA(1, 1, At, B1); PG8_BAR; PG8_SCHED8;
        }
        if constexpr (EB == 1) asm volatile("s_nop 15\n\ts_nop 15" ::: "memory");
        E(acc, cur, wr, wc, fr, fq);
        if (!has_next) break;
#pragma unroll
        for (int a = 0; a < 2; ++a)
#pragma unroll
            for (int b = 0; b < 2; ++b)
#pragma unroll
                for (int m = 0; m < 4; ++m)
#pragma unroll
                    for (int n = 0; n < 2; ++n) acc[a][b][m][n] = (f32x4){0.f, 0.f, 0.f, 0.f};
        cur = nxt; cA = nA; cB = nB; ++ui;
    }
    PG8_WAIT_V(0);
    if (wr == 0) PG8_BAR;
    PG8_BAR;
#undef PG8_SA
#undef PG8_SB
#undef PG8_STAGE
#undef PG8_LDA
#undef PG8_LDB
#undef PG8_MMA
#undef PG8_CAT8
#undef PG8_WAIT_V
#undef PG8_WAIT_L
#undef PG8_BAR
#undef PG8_SCHED
}
}
struct Params { const float* in[46]; float* out; unsigned char* ws; };
enum { I_X = 0, I_C, I_CTX, I_CCTX, I_ADAW, I_ADAB, I_NORMG, I_GWIN, I_GGV, I_GWS, I_GBS, I_GWOUT, I_LWIN, I_LCW, I_LCB, I_LWA, I_LBA, I_LWX, I_LBX, I_LLAM, I_LWOUT,
       I_HWIN, I_HCW, I_HCB, I_HFW1, I_HFB1, I_HFW2, I_HFB2, I_HFW3, I_HFB3, I_HFREQ, I_HFWOUT, I_HBIAS, I_HWOUT, I_PWIN, I_PWG, I_PBG, I_PSCALE, I_PWOUT,
       I_FWG, I_FWU, I_FWD, I_MWR, I_MWG, I_MWU, I_MWD };

struct Frame {
    LAS unsigned char* lds; int tid, lane, wave, G, vcu; const Params* P; unsigned char* ws;
};

__device__ __forceinline__ int fresh_tid_w(int wave) { return wave * 64 + lane_now(); }
__device__ __forceinline__ void ld_f32row(const float* p, int lane, f32x4 (&v)[4]) {
#pragma unroll
    for (int j = 0; j < 4; ++j) v[j] = *(const f32x4*)(p + 4 * lane + 256 * j);
}
__device__ __forceinline__ void st_f32row(float* p, int lane, const f32x4 (&v)[4]) {
#pragma unroll
    for (int j = 0; j < 4; ++j) *(f32x4*)(p + 4 * lane + 256 * j) = v[j];
}
__device__ __forceinline__ void ld_bf16row(const bf16_t* p, int lane, f32x4 (&v)[4]) {
#pragma unroll
    for (int j = 0; j < 4; ++j) { const u32x2 w = *(const u32x2*)(p + 4 * lane + 256 * j); v[j] = (f32x4){bflo(w.x), bfhi(w.x), bflo(w.y), bfhi(w.y)}; }
}
__device__ __forceinline__ void st_bf16row(bf16_t* p, int lane, const f32x4 (&v)[4]) {
#pragma unroll
    for (int j = 0; j < 4; ++j) { u32x2 w; w.x = pk2(v[j][0], v[j][1]); w.y = pk2(v[j][2], v[j][3]); *(u32x2*)(p + 4 * lane + 256 * j) = w; }
}
__device__ __forceinline__ float row_sumsq(const f32x4 (&v)[4]) {
    float s = 0.f;
#pragma unroll
    for (int j = 0; j < 4; ++j) s += (v[j][0] * v[j][0] + v[j][1] * v[j][1]) + (v[j][2] * v[j][2] + v[j][3] * v[j][3]);
    return wave_sum(s);
}

__device__ __forceinline__ void transpose_item(const float* W, int K, int N, bf16_t* WT, int k0, int n0, int drow0, LAS float* scr, int lane) {
#pragma unroll 8
    for (int i = 0; i < 32; ++i) { const int kk = 2 * i + (lane >> 5); scr[kk * 33 + (lane & 31)] = W[(size_t)(k0 + kk) * N + n0 + (lane & 31)]; }
    LDS_WAIT(); asm volatile("" ::: "memory");
    const int c = lane & 7;
#pragma unroll
    for (int j = 0; j < 4; ++j) { const int n = (lane >> 3) + 8 * j; const LAS float* s = scr + (8 * c) * 33 + n;
        u32x4 o; o.x = pk2(s[0 * 33], s[1 * 33]); o.y = pk2(s[2 * 33], s[3 * 33]); o.z = pk2(s[4 * 33], s[5 * 33]); o.w = pk2(s[6 * 33], s[7 * 33]);
        *(u32x4*)(WT + (size_t)(drow0 + n) * K + k0 + 8 * c) = o; }
    LDS_WAIT(); asm volatile("" ::: "memory");
}
__device__ __forceinline__ void conv_generic(const float* src, int K, int N, bf16_t* dst, int mode, int item, LAS float* scr, int lane) {
    const int nblk = N / 32, kb = item / nblk, nb = item % nblk, k0 = 64 * kb, n0 = 32 * nb;
    const int drow0 = mode == 0 ? n0 : (256 * (n0 >> 7) + (n0 & 127) + (mode == 2 ? 128 : 0));
    transpose_item(src, K, N, dst, k0, n0, drow0, scr, lane);
}
__device__ __forceinline__ void transpose_item8(const float* W, int K, int N, unsigned char* WT, int k0, int n0, int drow0, float wscale, LAS float* scr, int lane) {
    float v[32]; const float* wp = W + (size_t)(k0 + (lane >> 5)) * N + n0 + (lane & 31);
#pragma unroll
    for (int i = 0; i < 32; ++i) v[i] = wp[(size_t)(2 * i) * N];
#pragma unroll
    for (int i = 0; i < 32; ++i) scr[(2 * i + (lane >> 5)) * 33 + (lane & 31)] = v[i];
    LDS_WAIT(); asm volatile("" ::: "memory");
    const int c = lane & 7;
#pragma unroll
    for (int j = 0; j < 4; ++j) { const int n = (lane >> 3) + 8 * j; const LAS float* s = scr + (8 * c) * 33 + n;
        u32x2 o; o.x = pk4_fp8(s[0 * 33] * wscale, s[1 * 33] * wscale, s[2 * 33] * wscale, s[3 * 33] * wscale); o.y = pk4_fp8(s[4 * 33] * wscale, s[5 * 33] * wscale, s[6 * 33] * wscale, s[7 * 33] * wscale);
        *(u32x2*)(WT + (size_t)(drow0 + n) * K + k0 + 8 * c) = o; }
    LDS_WAIT(); asm volatile("" ::: "memory");
}
__device__ __forceinline__ void conv_generic8(const float* src, int K, int N, unsigned char* dst, int mode, int item, float wscale, LAS float* scr, int lane) {
    const int nblk = N / 32, kb = item / nblk, nb = item % nblk, k0 = 64 * kb, n0 = 32 * nb;
    const int drow0 = mode == 0 ? n0 : (256 * (n0 >> 7) + (n0 & 127) + (mode == 2 ? 128 : 0));
    transpose_item8(src, K, N, dst, k0, n0, drow0, wscale, scr, lane);
}
#ifndef FFN8_MASK
#define FFN8_MASK 2
#endif
#ifndef PIN8
#define PIN8 1
#endif
#ifndef LIN8
#define LIN8 0
#endif
#ifndef HIN8
#define HIN8 1
#endif
constexpr int FFN_SA1 = 3, FFN_SB1 = 6, FFN_SA2 = 2, FFN_SB2 = 7;
constexpr int NCONV_SMALL = 2048 + 1024 + 1024 + 512 + 1536 + 512 + 512 + 512 + 6 * 1408;
constexpr int NCONV_MOE = 8 * 3 * 1792;
__device__ __forceinline__ void conv_small_item(const Frame& F, int it, LAS float* scr) {
    const Params& P = *F.P; unsigned char* ws = F.ws; int r = it;
    if (r < 2048) { conv_generic(P.in[I_GWIN], 1024, 4096, (bf16_t*)(ws + W_GIN), 0, r, scr, F.lane); return; } r -= 2048;
    if (r < 1024) { conv_generic(P.in[I_GWOUT], 2048, 1024, (bf16_t*)(ws + W_GOUT), 0, r, scr, F.lane); return; } r -= 1024;
    if (r < 1024) { if (LIN8) conv_generic8(P.in[I_LWIN], 1024, 2048, ws + W_LIN, 0, r, (float)(1 << FFN_SB1), scr, F.lane); else conv_generic(P.in[I_LWIN], 1024, 2048, (bf16_t*)(ws + W_LIN), 0, r, scr, F.lane); return; } r -= 1024;
    if (r < 512) { conv_generic(P.in[I_LWOUT], 1024, 1024, (bf16_t*)(ws + W_LOUT), 0, r, scr, F.lane); return; } r -= 512;
    if (r < 1536) { if (HIN8) conv_generic8(P.in[I_HWIN], 1024, 3072, ws + W_HIN, 0, r, (float)(1 << FFN_SB1), scr, F.lane); else conv_generic(P.in[I_HWIN], 1024, 3072, (bf16_t*)(ws + W_HIN), 0, r, scr, F.lane); return; } r -= 1536;
    if (r < 512) { conv_generic(P.in[I_HWOUT], 1024, 1024, (bf16_t*)(ws + W_HOUT), 0, r, scr, F.lane); return; } r -= 512;
    if (r < 512) { if (PIN8) conv_generic8(P.in[I_PWIN], 1024, 1024, ws + W_PIN, 0, r, (float)(1 << FFN_SB1), scr, F.lane); else conv_generic(P.in[I_PWIN], 1024, 1024, (bf16_t*)(ws + W_PIN), 0, r, scr, F.lane); return; } r -= 512;
    if (r < 512) { conv_generic(P.in[I_PWOUT], 1024, 1024, (bf16_t*)(ws + W_POUT), 0, r, scr, F.lane); return; } r -= 512;
    const int which = r / 2816, rr = r % 2816, l = rr / 1408, item = rr % 1408;
    if ((FFN8_MASK >> l) & 1) {
        unsigned char* gu8 = ws + W_FGU + (size_t)l * 11 * MiB; unsigned char* d8 = ws + W_FD + (size_t)l * 11 * MiB / 2;
        if (which == 0) conv_generic8(P.in[I_FWG] + (size_t)l * 1024 * DFF, 1024, DFF, gu8, 1, item, (float)(1 << FFN_SB1), scr, F.lane);
        else if (which == 1) conv_generic8(P.in[I_FWU] + (size_t)l * 1024 * DFF, 1024, DFF, gu8, 2, item, (float)(1 << FFN_SB1), scr, F.lane);
        else conv_generic8(P.in[I_FWD] + (size_t)l * DFF * 1024, DFF, 1024, d8, 0, item, (float)(1 << FFN_SB2), scr, F.lane);
    } else {
        bf16_t* gu = (bf16_t*)(ws + W_FGU + (size_t)l * 11 * MiB); bf16_t* dd = (bf16_t*)(ws + W_FD + (size_t)l * 11 * MiB / 2);
        if (which == 0) conv_generic(P.in[I_FWG] + (size_t)l * 1024 * DFF, 1024, DFF, gu, 1, item, scr, F.lane);
        else if (which == 1) conv_generic(P.in[I_FWU] + (size_t)l * 1024 * DFF, 1024, DFF, gu, 2, item, scr, F.lane);
        else conv_generic(P.in[I_FWD] + (size_t)l * DFF * 1024, DFF, 1024, dd, 0, item, scr, F.lane);
    }
}
static_assert(true, ""); constexpr int MOE_SA1 = 3, MOE_SB1 = 6, MOE_SA2 = 2, MOE_SB2 = 7;
constexpr size_t WM_LAYER = 84 * MiB, WM_DOFF = 56 * MiB;
__device__ __forceinline__ void conv_moe_item(const Frame& F, int layer, int it, LAS float* scr) {
    const Params& P = *F.P; unsigned char* ws = F.ws;
    const int e = it / 5376, r = it % 5376, which = r / 1792, item = r % 1792; const size_t eo = (size_t)(layer * NEXP + e);
    unsigned char* gu = ws + WS_WMOE + (size_t)layer * WM_LAYER + (size_t)e * 2 * EFF * 1024; unsigned char* dd = ws + WS_WMOE + (size_t)layer * WM_LAYER + WM_DOFF + (size_t)e * 1024 * EFF;
    if (which == 0) conv_generic8(P.in[I_MWG] + eo * 1024 * EFF, 1024, EFF, gu, 1, item, (float)(1 << MOE_SB1), scr, F.lane);
    else if (which == 1) conv_generic8(P.in[I_MWU] + eo * 1024 * EFF, 1024, EFF, gu, 2, item, (float)(1 << MOE_SB1), scr, F.lane);
    else conv_generic8(P.in[I_MWD] + eo * EFF * 1024, EFF, 1024, dd, 0, item, (float)(1 << MOE_SB2), scr, F.lane);
}
#ifndef SLQ0
#define SLQ0 0
#define SLQ1 0
#define SLQ2 0
#define SLQ3 0
#define SLQ4 0
#define SLQ5 0
#endif
constexpr int SL_Q[6] = {SLQ0, SLQ1, SLQ2, SLQ3, SLQ4, SLQ5};
constexpr int SL_FIRST[6] = {(MT / 256 * 16) % 256, (MT / 256 * 4) % 256, (MT / 256 * 22) % 256, (MT / 256 * 4) % 256, (MT / 256 * 8) % 256, 8};
constexpr int sl_base(int s) { int b = 0; for (int i = 0; i < s; ++i) b += (256 - SL_FIRST[i]) * 8 * SL_Q[i]; return b; }
constexpr int SL_TOTAL = sl_base(6) < 2 * NCONV_MOE ? sl_base(6) : 2 * NCONV_MOE;
__device__ __forceinline__ void conv_slot(const Frame& F0, int s, int rank  ) {
    Frame F = F0; F.tid = fresh_tid_w(F0.wave); F.lane = F.tid & 63;
    LAS float* scr = (LAS float*)(F.lds + F.wave * 16384);
    const int base = sl_base(s), q = SL_Q[s], nw = (256 - SL_FIRST[s]) * 8, w = rank * 8 + F.wave;
    for (int n = 0; n < q; ++n) { const int it = base + n * nw + w;
        if (it < 2 * NCONV_MOE) conv_moe_item(F, it >= NCONV_MOE ? 1 : 0, it >= NCONV_MOE ? it - NCONV_MOE : it, scr); }
}
__device__ __forceinline__ int qperm(int n) { return (((n & 31) << 5) + ((n >> 5) & 31)) * 32 + (n >> 10); }

__device__ __forceinline__ void p0_prologue(const Frame& F0) {
    Frame F = F0; F.tid = fresh_tid_w(F0.wave); F.lane = F.tid & 63;
    const Params& P = *F.P; unsigned char* ws = F.ws;
    const int gw = F.vcu * NWAVES + F.wave, NGW = F.G * NWAVES; const int lane = F.lane;
    {
        LAS float* sv = (LAS float*)(F.lds);
        LAS float* red = (LAS float*)(F.lds + 16384);
        for (int i = F.tid; i < 3 * 1024; i += NTHR) { const int r = i >> 10, k = i & 1023; const float v = r < 2 ? P.in[I_C][r * 1024 + k] : P.in[I_CCTX][k]; sv[i] = siluf_(v); }
        __syncthreads();
        for (int unit = F.vcu; unit < 4 * 48; unit += F.G) {
            const int li = unit / 48, col0 = (unit % 48) * 128; const int kp = F.tid >> 5, n4 = F.tid & 31;
            f32x4 a0 = {0.f, 0.f, 0.f, 0.f}, a1 = a0, a2 = a0;
            const float* wp = P.in[I_ADAW] + ((size_t)li * 1024 + kp * 64) * 6144 + col0 + 4 * n4;
#pragma unroll 8
            for (int k = 0; k < 64; ++k) { const f32x4 w = *(const f32x4*)(wp + (size_t)k * 6144); const int kk = kp * 64 + k;
                a0 += w * sv[kk]; a1 += w * sv[1024 + kk]; a2 += w * sv[2048 + kk]; }
            *(LAS f32x4*)(red + (kp * 3 + 0) * 128 + 4 * n4) = a0; *(LAS f32x4*)(red + (kp * 3 + 1) * 128 + 4 * n4) = a1; *(LAS f32x4*)(red + (kp * 3 + 2) * 128 + 4 * n4) = a2;
            __syncthreads();
            if (F.tid < 384) { const int r = F.tid >> 7, cc = F.tid & 127; float s = P.in[I_ADAB][li * 6144 + col0 + cc];
#pragma unroll
                for (int p = 0; p < 16; ++p) s += red[(p * 3 + r) * 128 + cc];
                ((float*)(ws + WS_MOD))[((size_t)li * 3 + r) * 6144 + col0 + cc] = s; }
            __syncthreads();
        }
    }
    {
        float* pe = (float*)(ws + WS_PE);
        for (int i = (F.vcu * NTHR + F.tid); i < 320 * 512; i += F.G * NTHR) { const int p = i >> 9, j = i & 511, k = j & 255;
            const float omega = 1.0f / powf(10000.0f, (float)k / 256.0f); const float pos = (float)(p < 256 ? p : p - 256); const float ang = pos * omega;
            pe[i] = (j < 256) ? sinf(ang) : cosf(ang); }
    }
    {
        const int gt = F.vcu * NTHR + F.tid, NGT = F.G * NTHR;
        bf16_t* ws16 = (bf16_t*)(ws + WS_WS16);
        for (int i = gt; i < 8 * 128 * 128; i += NGT) ws16[i] = (bf16_t)f2bf(P.in[I_GWS][i]);
        bf16_t* lw = (bf16_t*)(ws + WS_LRUW);
        for (int i = gt; i < 8 * 512 * 128; i += NGT) { const int k = i & 127, R = (i >> 7) & 511, h = i >> 16; const int jb = R >> 6, nt = (R >> 4) & 3, jj = R & 15, j = 16 * jb + jj;
            const float* src = (nt & 1) ? P.in[I_LWX] : P.in[I_LWA]; const int dir = nt >> 1;
            lw[i] = (bf16_t)f2bf(src[(((size_t)dir * 8 + h) * 128 + k) * 128 + j]); }
        bf16_t* pw = (bf16_t*)(ws + WS_POOLW);
        for (int i = gt; i < 4 * 256 * 256; i += NGT) { const int c = i & 255, d = (i >> 8) & 255, g = i >> 16; pw[i] = (bf16_t)f2bf(P.in[I_PWG][((size_t)g * 256 + c) * 256 + d]); }
        bf16_t* hw = (bf16_t*)(ws + WS_HYW);
        for (int i = gt; i < 2048 * 256; i += NGT) { const int k = i & 255, row = i >> 8, o = row >> 10, ch = row & 1023;
            float v = 0.f; if (k < 128) v = P.in[I_HFWOUT][(size_t)(k & 63) * 4096 + o * 2048 + (k >> 6) * 1024 + ch]; hw[i] = (bf16_t)f2bf(v); }
    }
    {
        bf16_t* hq = (bf16_t*)(ws + WS_HQ);
        const float* w1 = P.in[I_HFW1]; const float* b1 = P.in[I_HFB1]; const float* w2 = P.in[I_HFW2]; const float* b2 = P.in[I_HFB2]; const float* w3 = P.in[I_HFW3]; const float* b3 = P.in[I_HFB3]; const float* fq = P.in[I_HFREQ];
        const float b1l = b1[lane], b2l = b2[lane], b3l = b3[lane], f1l = fq[lane], f2l = fq[64 + lane], f3l = fq[128 + lane];
        for (int t0 = gw; t0 < SEQ; t0 += 4 * NGW) {
            int tt[4]; float zv[4], acc[4], h[4];
#pragma unroll
            for (int q = 0; q < 4; ++q) { tt[q] = t0 + q * NGW; const int t = tt[q] < SEQ ? tt[q] : SEQ - 1;
                const float tn = (float)t * (1.0f / 16383.0f); const float wt = 6.283185307179586f * (float)t / 16384.0f;
                zv[q] = 0.f;
                if (lane == 0) zv[q] = tn;
                else if (lane <= 32) { const int bb = (lane - 1) & 15; const float band = 1e-4f + (float)bb * ((15.0f - 1e-4f) / 15.0f); const float a = band * wt; zv[q] = (lane <= 16) ? cosf(a) : sinf(-a); }
                acc[q] = b1l; }
#pragma unroll
            for (int i = 0; i < 33; ++i) { const float w = w1[i * 64 + lane];
#pragma unroll
                for (int q = 0; q < 4; ++q) acc[q] += __shfl(zv[q], i) * w; }
#pragma unroll
            for (int q = 0; q < 4; ++q) { h[q] = sinf(f1l * acc[q]); acc[q] = b2l; }
#pragma unroll 16
            for (int i = 0; i < 64; ++i) { const float w = w2[i * 64 + lane];
#pragma unroll
                for (int q = 0; q < 4; ++q) acc[q] += __shfl(h[q], i) * w; }
#pragma unroll
            for (int q = 0; q < 4; ++q) { h[q] = sinf(f2l * acc[q]); acc[q] = b3l; }
#pragma unroll 16
            for (int i = 0; i < 64; ++i) { const float w = w3[i * 64 + lane];
#pragma unroll
                for (int q = 0; q < 4; ++q) acc[q] += __shfl(h[q], i) * w; }
#pragma unroll
            for (int q = 0; q < 4; ++q) { const int t = tt[q]; const float hh = sinf(f3l * acc[q]);
                const int src = 4 * (lane & 15);
                const float h0 = __shfl(hh, src), h1 = __shfl(hh, src + 1), h2 = __shfl(hh, src + 2), h3 = __shfl(hh, src + 3);
                u32x2 val; val.x = pk2(h0, h1); val.y = pk2(h2, h3); const u32x2 zero = {0u, 0u};
                if (t < SEQ) {
                    *(u32x2*)(hq + (size_t)qperm(t) * 256 + 4 * lane) = (lane < 16) ? val : zero;
                    if (t >= 1) *(u32x2*)(hq + (size_t)qperm(32768 - t) * 256 + 4 * lane) = (lane >= 16 && lane < 32) ? val : zero;
                    else *(u32x2*)(hq + (size_t)qperm(16384) * 256 + 4 * lane) = zero; } }
        }
    }
    {
        LAS float* scr = (LAS float*)(F.lds + 32768 + F.wave * 8704);
        __syncthreads();
        for (int it = gw; it < NCONV_SMALL; it += NGW) conv_small_item(F, it, scr);
        for (int it = (F.G == 256 ? SL_TOTAL : 0) + gw; it < 2 * NCONV_MOE; it += NGW) conv_moe_item(F, it >= NCONV_MOE ? 1 : 0, it >= NCONV_MOE ? it - NCONV_MOE : it, scr);
    }
}
__device__ __forceinline__ void ld_vec(const float* p, int lane, f32x4 (&v)[4]) { ld_f32row(p, lane, v); }

__device__ __forceinline__ void norm1_phase(const Frame& F0) {
    Frame F = F0; F.tid = fresh_tid_w(F0.wave); F.lane = F.tid & 63;
    const Params& P = *F.P; unsigned char* ws = F.ws; const int lane = F.lane;
    const float* mod = (const float*)(ws + WS_MOD); const float* pe = (const float*)(ws + WS_PE); bf16_t* H = (bf16_t*)(ws + WS_H);
    f32x4 g[4]; ld_vec(P.in[I_NORMG], lane, g);
    for (int blk = F.vcu; blk < 256; blk += F.G) {
        {
            const int row0 = blk * 128 + F.wave * 16, b = row0 >> 14;
            f32x4 sh[4], sc[4]; ld_vec(mod + (size_t)b * 6144, lane, sh); ld_vec(mod + (size_t)b * 6144 + 1024, lane, sc);
            f32x4 qx[2][4], qp[2][4];
#define N1_ISSUE(i_, s_) do { const int m_ = row0 + (i_), t_ = m_ & 16383, r_ = t_ >> 6, c_ = t_ & 63; ld_f32row(P.in[I_X] + (size_t)m_ * D, lane, qx[s_]); \
                qp[s_][0] = *(const f32x4*)(pe + r_ * 512 + 4 * lane); qp[s_][1] = *(const f32x4*)(pe + r_ * 512 + 256 + 4 * lane); \
                qp[s_][2] = *(const f32x4*)(pe + (256 + c_) * 512 + 4 * lane); qp[s_][3] = *(const f32x4*)(pe + (256 + c_) * 512 + 256 + 4 * lane); } while (0)
#define N1_BODY(i_, s_) do { const int m = row0 + (i_); f32x4 x[4]; \
                _Pragma("unroll") for (int j = 0; j < 4; ++j) x[j] = qx[s_][j] + qp[s_][j]; \
                if ((i_) + 2 < 16) N1_ISSUE((i_) + 2, s_); \
                asm volatile("" ::: "memory"); \
                st_bf16row((bf16_t*)(ws + WS_XB) + (size_t)m * D, lane, x); \
                const float rr = rsqrtf(row_sumsq(x) * (1.0f / D) + EPS); \
                _Pragma("unroll") for (int j = 0; j < 4; ++j) x[j] = (x[j] * rr * g[j]) * (1.0f + sc[j]) + sh[j]; \
                st_bf16row(H + (size_t)m * D, lane, x); } while (0)
            N1_ISSUE(0, 0); N1_ISSUE(1, 1);
#pragma unroll 1
            for (int i = 0; i < 16; i += 2) { N1_BODY(i, 0); N1_BODY(i + 1, 1); }
        }
        const int gwi = blk * 8 + F.wave;
        if (gwi < 32) {
            f32x4 sh[4], sc[4]; ld_vec(mod + (size_t)2 * 6144, lane, sh); ld_vec(mod + (size_t)2 * 6144 + 1024, lane, sc);
            for (int i = 0; i < 16; ++i) { const int m = gwi * 16 + i;
                f32x4 x[4]; ld_f32row(P.in[I_CTX] + (size_t)m * D, lane, x);
                st_f32row((float*)(ws + WS_XC) + (size_t)m * D, lane, x);
                const float rr = rsqrtf(row_sumsq(x) * (1.0f / D) + EPS);
#pragma unroll
                for (int j = 0; j < 4; ++j) x[j] = (x[j] * rr * g[j]) * (1.0f + sc[j]) + sh[j];
                st_bf16row(H + (size_t)(ML + m) * D, lane, x); }
        }
    }
}

__device__ __forceinline__ void st_fp8row(unsigned char* p, int lane, const f32x4 (&v)[4], float sc) {
#pragma unroll
    for (int j = 0; j < 4; ++j) *(unsigned*)(p + 4 * lane + 256 * j) = pk4_fp8(v[j][0] * sc, v[j][1] * sc, v[j][2] * sc, v[j][3] * sc);
}
template <bool HAS_NEXT, bool H8, bool X16>
__device__ __forceinline__ void post_row(const bool dry, f32x4 (&y)[4], f32x4 (&x)[4], float* xrow, bf16_t* hrow, int lane, const f32x4 (&gA)[4], const f32x4 (&gate)[4], const f32x4 (&gB)[4], const f32x4 (&sc)[4], const f32x4 (&sh)[4], f32x4 (&hf)[4]) {
    const float ry = rsqrtf(row_sumsq(y) * (1.0f / D) + EPS);
#pragma unroll
    for (int j = 0; j < 4; ++j) x[j] += gate[j] * (y[j] * ry * gA[j]);
    if (!dry) { if (X16) st_bf16row((bf16_t*)xrow, lane, x); else st_f32row(xrow, lane, x); }
    if (HAS_NEXT) {
        const float rx = rsqrtf(row_sumsq(x) * (1.0f / D) + EPS);
#pragma unroll
        for (int j = 0; j < 4; ++j) hf[j] = (x[j] * rx * gB[j]) * (1.0f + sc[j]) + sh[j];
        if (!dry) { if (H8) st_fp8row((unsigned char*)hrow, lane, hf, (float)(1 << FFN_SA1)); else st_bf16row(hrow, lane, hf); }
    }
}

__device__ __forceinline__ void post_route(const bool dry, const f32x4 (&hf)[4], const LAS float* wr, LAS int* hist, unsigned* rt, int lane) {
    float lg[8];
#pragma unroll
    for (int e = 0; e < 8; ++e) lg[e] = 0.f;
#pragma unroll
    for (int j = 0; j < 4; ++j)
#pragma unroll
        for (int r = 0; r < 4; ++r) { const int c = 4 * lane + 256 * j + r; const f32x4 w0 = *(const LAS f32x4*)(wr + c * 8), w1 = *(const LAS f32x4*)(wr + c * 8 + 4); const float hv = hf[j][r];
            lg[0] += hv * w0[0]; lg[1] += hv * w0[1]; lg[2] += hv * w0[2]; lg[3] += hv * w0[3]; lg[4] += hv * w1[0]; lg[5] += hv * w1[1]; lg[6] += hv * w1[2]; lg[7] += hv * w1[3]; }
#pragma unroll
    for (int e = 0; e < 8; ++e) lg[e] = wave_sum(lg[e]);
    int e0 = 0; float v0 = lg[0];
#pragma unroll
    for (int e = 1; e < 8; ++e) if (lg[e] > v0) { v0 = lg[e]; e0 = e; }
    int e1 = -1; float v1 = -3.0e38f;
#pragma unroll
    for (int e = 0; e < 8; ++e) if (e != e0 && lg[e] > v1) { v1 = lg[e]; e1 = e; }
    const float p1 = 1.0f / (1.0f + __expf(v0 - v1)), p0 = 1.0f - p1;
    if (lane == 0 && !dry) { rt[0] = (unsigned)e0 | ((unsigned)e1 << 8); rt[1] = __builtin_bit_cast(unsigned, p0); rt[2] = __builtin_bit_cast(unsigned, p1);
        __hip_atomic_fetch_add(&hist[e0], 1, __ATOMIC_RELAXED, __HIP_MEMORY_SCOPE_WORKGROUP); __hip_atomic_fetch_add(&hist[e1], 1, __ATOMIC_RELAXED, __HIP_MEMORY_SCOPE_WORKGROUP); }
}

template <bool MOE_IN, bool ROUTE, bool HAS_NEXT, bool DO_CTX, bool H8 = false, bool FIRSTX = false>
__device__ __forceinline__ void post_phase(const Frame& F0, int li, int sub, const bool dry = false) {
    Frame F = F0; F.tid = fresh_tid_w(F0.wave); F.lane = F.tid & 63;
    const Params& P = *F.P; unsigned char* ws = F.ws; const int lane = F.lane;
    const float* mod = (const float*)(ws + WS_MOD); bf16_t* H = (bf16_t*)(ws + WS_H); const bf16_t* Y = (const bf16_t*)(ws + WS_Y);
    unsigned* route = (unsigned*)(ws + WS_ROUTE);
    const int ka = sub == 1 ? 1 : 3, gate_off = sub == 1 ? 2048 : 5120;
    const int li2 = sub == 1 ? li : li + 1, kb = sub == 1 ? 2 : 0, sh_off = sub == 1 ? 3072 : 0, sc_off = sub == 1 ? 4096 : 1024;
    f32x4 gA[4], gB[4]; ld_vec(P.in[I_NORMG] + (size_t)(li * 4 + ka) * D, lane, gA);
    if (HAS_NEXT) ld_vec(P.in[I_NORMG] + (size_t)(li2 * 4 + kb) * D, lane, gB);
    LAS float* wr = (LAS float*)(F.lds);
    LAS int* hist = (LAS int*)(F.lds + 32768);
    if (ROUTE) {
        const float* src = P.in[I_MWR] + (size_t)(li >> 1) * 1024 * 8;
        for (int i = F.tid; i < 8192; i += NTHR) wr[i] = src[i];
        __syncthreads();
    }
    for (int blk = F.vcu; blk < 256; blk += F.G) {
        if (ROUTE) { if (F.tid < 8) hist[F.tid] = 0; __syncthreads(); }
        {
            const int row0 = blk * 128 + F.wave * 16, b = row0 >> 14;
            f32x4 gate[4], sc[4], sh[4]; ld_vec(mod + ((size_t)li * 3 + b) * 6144 + gate_off, lane, gate);
            if (HAS_NEXT) { ld_vec(mod + ((size_t)li2 * 3 + b) * 6144 + sc_off, lane, sc); ld_vec(mod + ((size_t)li2 * 3 + b) * 6144 + sh_off, lane, sh); }
            bf16_t* XB = (bf16_t*)(ws + WS_XB);
            unsigned rc1 = 0u, rc2 = 0u, rc3 = 0u, rc4 = 0u;
            if (MOE_IN) { const unsigned* rt_ = route + (size_t)(row0 + (lane & 15)) * 8; rc1 = rt_[1]; rc2 = rt_[2]; rc3 = rt_[3]; rc4 = rt_[4]; }
            constexpr int PD = (MOE_IN || ROUTE) ? 3 : 4;
            u32x2 qy[4][4], qz[4][4], qx[4][4]; float qp0[4], qp1[4];
#define POST_LDRAW(p_, q_) do { _Pragma("unroll") for (int j_ = 0; j_ < 4; ++j_) q_[j_] = *(const u32x2*)((p_) + 4 * lane + 256 * j_); } while (0)
#define POST_ISSUE(i_, s_) do { const int m_ = row0 + (i_); \
                if (MOE_IN) { qp0[s_] = __builtin_bit_cast(float, __builtin_amdgcn_readlane(rc1, (i_))); qp1[s_] = __builtin_bit_cast(float, __builtin_amdgcn_readlane(rc2, (i_))); \
                    const unsigned a_ = __builtin_amdgcn_readlane(rc3, (i_)), b_ = __builtin_amdgcn_readlane(rc4, (i_)); POST_LDRAW(Y + (size_t)a_ * D, qy[s_]); POST_LDRAW(Y + (size_t)b_ * D, qz[s_]); } \
                else POST_LDRAW(Y + (size_t)m_ * D, qy[s_]); \
                POST_LDRAW(XB + (size_t)m_ * D, qx[s_]); } while (0)
#define POST_BODY(i_, s_) do { const int m = row0 + (i_); f32x4 y[4], x[4], hf[4]; \
                _Pragma("unroll") for (int j = 0; j < 4; ++j) { \
                    if (MOE_IN) y[j] = (f32x4){qp0[s_] * bflo(qy[s_][j].x) + qp1[s_] * bflo(qz[s_][j].x), qp0[s_] * bfhi(qy[s_][j].x) + qp1[s_] * bfhi(qz[s_][j].x), qp0[s_] * bflo(qy[s_][j].y) + qp1[s_] * bflo(qz[s_][j].y), qp0[s_] * bfhi(qy[s_][j].y) + qp1[s_] * bfhi(qz[s_][j].y)}; \
                    else y[j] = (f32x4){bflo(qy[s_][j].x), bfhi(qy[s_][j].x), bflo(qy[s_][j].y), bfhi(qy[s_][j].y)}; \
                    x[j] = (f32x4){bflo(qx[s_][j].x), bfhi(qx[s_][j].x), bflo(qx[s_][j].y), bfhi(qx[s_][j].y)}; } \
                if ((i_) + PD < 16) POST_ISSUE((i_) + PD, s_); \
                asm volatile("" ::: "memory");                        \
                post_row<HAS_NEXT, H8, HAS_NEXT>(dry, y, x, HAS_NEXT ? (float*)(XB + (size_t)m * D) : P.out + (size_t)m * D, H8 ? (bf16_t*)((unsigned char*)H + (size_t)m * D) : H + (size_t)m * D, lane, gA, gate, gB, sc, sh, hf); \
                if (ROUTE) post_route(dry, hf, wr, hist, route + (size_t)m * 8, lane); } while (0)
            POST_ISSUE(0, 0); POST_ISSUE(1, 1); if (PD > 2) POST_ISSUE(2, 2); if (PD > 3) POST_ISSUE(3, 3);
#pragma unroll 1
            for (int i = 0; i < 16; i += PD) { POST_BODY(i, 0); if (i + 1 < 16) POST_BODY(i + 1, 1); if (PD > 2 && i + 2 < 16) POST_BODY(i + 2, 2); if (PD > 3) POST_BODY(i + 3, 3); }
        }
        if (DO_CTX) { const int gwi = blk * 8 + F.wave;
            if (gwi < 32) {
                f32x4 gate[4], sc[4], sh[4]; ld_vec(mod + ((size_t)li * 3 + 2) * 6144 + gate_off, lane, gate);
                if (HAS_NEXT) { ld_vec(mod + ((size_t)li2 * 3 + 2) * 6144 + sc_off, lane, sc); ld_vec(mod + ((size_t)li2 * 3 + 2) * 6144 + sh_off, lane, sh); }
                for (int i = 0; i < 16; ++i) { const int m = gwi * 16 + i; f32x4 y[4], x[4], hf[4]; ld_bf16row(Y + (size_t)(ML + m) * D, lane, y); ld_f32row((float*)(ws + WS_XC) + (size_t)m * D, lane, x);
                    post_row<HAS_NEXT, H8, false>(dry, y, x, (float*)(ws + WS_XC) + (size_t)m * D, H8 ? (bf16_t*)((unsigned char*)H + (size_t)(ML + m) * D) : H + (size_t)(ML + m) * D, lane, gA, gate, gB, sc, sh, hf); }
            } }
        if (ROUTE) { __syncthreads(); if (F.tid < 8 && !dry) ((int*)(ws + WS_COUNTS))[blk * 8 + F.tid] = hist[F.tid]; __syncthreads(); }
    }
}

__device__ __forceinline__ void vstats_phase(const Frame& F0) {
    Frame F = F0; F.tid = fresh_tid_w(F0.wave); F.lane = F.tid & 63;
    const bf16_t* UV = (const bf16_t*)(F.ws + WS_BIG); float* st = (float*)(F.ws + WS_ROWSTAT);
    const int gw = F.vcu * NWAVES + F.wave, NGW = F.G * NWAVES;
    for (int m0 = gw; m0 < MT; m0 += 4 * NGW) {
        u32x4 w[4][4];
#pragma unroll
        for (int r = 0; r < 4; ++r) { int m = m0 + r * NGW; m = m < MT ? m : MT - 1; const bf16_t* p = UV + (size_t)m * 4096 + 2048 + 8 * F.lane;
#pragma unroll
            for (int j = 0; j < 4; ++j) w[r][j] = *(const u32x4*)(p + 512 * j); }
        asm volatile("" ::: "memory");
#pragma unroll
        for (int r = 0; r < 4; ++r) { const int m = m0 + r * NGW; float s = 0.f, q = 0.f;
#pragma unroll
            for (int j = 0; j < 4; ++j)
#pragma unroll
                for (int k = 0; k < 4; ++k) { const float a = bflo(w[r][j][k]), b = bfhi(w[r][j][k]); s += a + b; q += a * a + b * b; }
            s = wave_sum(s); q = wave_sum(q); const float mu = s * (1.0f / 2048.0f); const float var = fmaxf(q * (1.0f / 2048.0f) - mu * mu, 0.f);
            if (F.lane == 0 && m < MT) { st[2 * m] = mu; st[2 * m + 1] = rsqrtf(var + EPS); } } }
}

__device__ __forceinline__ void spatial_phase(const Frame& F0) {
    Frame F = F0; F.tid = fresh_tid_w(F0.wave); F.lane = F.tid & 63;
    const Params& P = *F.P; unsigned char* ws = F.ws; const int tid = F.tid, lane = F.lane, w = F.wave, fr = lane & 15, fq = lane >> 4;
    const bf16_t* UV = (const bf16_t*)(ws + WS_BIG); bf16_t* S = (bf16_t*)(ws + WS_BIG + 260 * MiB); const bf16_t* WS16 = (const bf16_t*)(ws + WS_WS16); const float* st = (const float*)(ws + WS_ROWSTAT);
    LAS unsigned char* ldsA = F.lds; LAS unsigned char* ldsV = F.lds + 34816; LAS float* lst = (LAS float*)(F.lds + 102400);
    int gcache = -1;
    for (int unit = F.vcu; unit < (MT / 128) * 8; unit += F.G) {
        const int chunk = unit >> 3, g = unit & 7, row0 = chunk * 128;
        if (g != gcache) { gcache = g;
#pragma unroll
            for (int i = 0; i < 4; ++i) { const int idx = tid + 512 * i, r = idx >> 4, c16 = idx & 15; *(LAS u32x4*)(ldsA + r * 272 + c16 * 16) = *(const u32x4*)(WS16 + ((size_t)g * 128 + r) * 128 + c16 * 8); } }
#pragma unroll
        for (int i = 0; i < 8; ++i) { const int idx = tid + 512 * i, s = idx >> 5, c8 = idx & 31;
            const u32x4 wv = *(const u32x4*)(UV + (size_t)(row0 + s) * 4096 + 2048 + 256 * g + 8 * c8);
            const float mu = st[2 * (row0 + s)], rs = st[2 * (row0 + s) + 1];
            const f32x4 g0 = *(const f32x4*)(P.in[I_GGV] + 256 * g + 8 * c8), g1 = *(const f32x4*)(P.in[I_GGV] + 256 * g + 8 * c8 + 4);
            u32x4 o; o.x = pk2((bflo(wv.x) - mu) * rs * g0[0], (bfhi(wv.x) - mu) * rs * g0[1]); o.y = pk2((bflo(wv.y) - mu) * rs * g0[2], (bfhi(wv.y) - mu) * rs * g0[3]);
            o.z = pk2((bflo(wv.z) - mu) * rs * g1[0], (bfhi(wv.z) - mu) * rs * g1[1]); o.w = pk2((bflo(wv.w) - mu) * rs * g1[2], (bfhi(wv.w) - mu) * rs * g1[3]);
            *(LAS u32x4*)(ldsV + s * 528 + c8 * 16) = o; }
        __syncthreads();
        u32x2 uq[8][2]; float bsq[8];
#pragma unroll
        for (int m = 0; m < 8; ++m) { const int t = 16 * m + fr; bsq[m] = P.in[I_GBS][g * 128 + t];
#pragma unroll
            for (int n = 0; n < 2; ++n) uq[m][n] = *(const u32x2*)(UV + (size_t)(row0 + t) * 4096 + 256 * g + 32 * w + 16 * n + 4 * fq); }
        asm volatile("" ::: "memory");
        f32x4 acc[8][2];
#pragma unroll
        for (int m = 0; m < 8; ++m) { acc[m][0] = (f32x4){0.f, 0.f, 0.f, 0.f}; acc[m][1] = acc[m][0]; }
#pragma unroll
        for (int ks = 0; ks < 4; ++ks) {
            bf16x8 b[2];
#pragma unroll
            for (int n = 0; n < 2; ++n)
#pragma unroll
                for (int j = 0; j < 8; ++j) b[n][j] = *(const LAS short*)(ldsV + (32 * ks + 8 * fq + j) * 528 + (32 * w + 16 * n + fr) * 2);
#pragma unroll
            for (int m = 0; m < 8; ++m) { const bf16x8 a = *(const LAS bf16x8*)(ldsA + (16 * m + fr) * 272 + ks * 64 + fq * 16);
                acc[m][0] = __builtin_amdgcn_mfma_f32_16x16x32_bf16(b[0], a, acc[m][0], 0, 0, 0); acc[m][1] = __builtin_amdgcn_mfma_f32_16x16x32_bf16(b[1], a, acc[m][1], 0, 0, 0); }
        }
#pragma unroll
        for (int m = 0; m < 8; ++m) { const int t = 16 * m + fr; const size_t row = (size_t)(row0 + t); const float bs = bsq[m];
#pragma unroll
            for (int n = 0; n < 2; ++n) { const int c = 256 * g + 32 * w + 16 * n + 4 * fq; const u32x2 uu = uq[m][n];
                u32x2 o; o.x = pk2((acc[m][n][0] + bs) * bflo(uu.x), (acc[m][n][1] + bs) * bfhi(uu.x)); o.y = pk2((acc[m][n][2] + bs) * bflo(uu.y), (acc[m][n][3] + bs) * bfhi(uu.y));
                *(u32x2*)(S + row * 2048 + c) = o; } }
        __syncthreads();
    }
}
constexpr size_t LRU_LA = 130 * MiB, LRU_BB = 260 * MiB;

__device__ __forceinline__ void lru_gates_phase(const Frame& F0) {
    Frame F = F0; F.tid = fresh_tid_w(F0.wave); F.lane = F.tid & 63;
    const Params& P = *F.P; unsigned char* ws = F.ws; const int w = F.wave;
    const bf16_t* GXB = (const bf16_t*)(ws + WS_BIG); bf16_t* LA = (bf16_t*)(ws + WS_BIG + LRU_LA); bf16_t* BB = (bf16_t*)(ws + WS_BIG + LRU_BB); const bf16_t* LW = (const bf16_t*)(ws + WS_LRUW);
    LAS unsigned char* ldsX = F.lds; LAS unsigned* stg = (LAS unsigned*)(F.lds + 34816); LAS f32x2* hx = (LAS f32x2*)(F.lds + 102400);
    float* AGG = (float*)(ws + WS_AGG);
    LAS float* prm = (LAS float*)(F.lds + 104448);
    int hcache = -1;
    for (int unit = F.vcu; unit < (MT / 128) * 8; unit += F.G) {
        const int tid = fresh_tid_w(w);
        const int lane = tid & 63, fr = lane & 15, fq = lane >> 4;
        const int rt = unit >> 3, h = unit & 7, row0 = rt * 128;
        if (h != hcache) { hcache = h;
            if (tid < 256) { const int d = tid >> 7, c = tid & 127, chg = d * 1024 + 128 * h + c;
                prm[(0 * 2 + d) * 128 + c] = P.in[I_LBA][chg]; prm[(1 * 2 + d) * 128 + c] = P.in[I_LBX][chg]; prm[(2 * 2 + d) * 128 + c] = log1pf(fexp_(-P.in[I_LLAM][chg])); } }
        int s0, s1; if (row0 < ML) { s0 = (row0 >> 14) << 14; s1 = s0 + SEQ; } else { s0 = ML + (((row0 - ML) >> 8) << 8); s1 = s0 + CTXL; }
        { const int c8 = tid & 15, tb = tid >> 4, ch0 = 128 * h + 8 * c8;
            f32x4 wq[4][2], bq[2]; bq[0] = *(const f32x4*)(P.in[I_LCB] + ch0); bq[1] = *(const f32x4*)(P.in[I_LCB] + ch0 + 4);
#pragma unroll
            for (int k = 0; k < 4; ++k) { const float zs = LIN8 ? 1.0f / (float)(1 << (FFN_SA1 + FFN_SB1)) : 1.0f;
                wq[k][0] = *(const f32x4*)(P.in[I_LCW] + k * 1024 + ch0) * zs; wq[k][1] = *(const f32x4*)(P.in[I_LCW] + k * 1024 + ch0 + 4) * zs; }
            u32x4 xv[4][4];
#pragma unroll
            for (int i = 0; i < 4; ++i)
#pragma unroll
                for (int k = 0; k < 4; ++k) { int r = row0 + tb + 32 * i + k - 2; r = r < s0 ? s0 : (r > s1 - 1 ? s1 - 1 : r); xv[i][k] = *(const u32x4*)(GXB + (size_t)r * 2048 + 1024 + ch0); }
            asm volatile("" ::: "memory");
#pragma unroll
            for (int i = 0; i < 4; ++i) { const int t = tb + 32 * i;
                float a[8] = {bq[0][0], bq[0][1], bq[0][2], bq[0][3], bq[1][0], bq[1][1], bq[1][2], bq[1][3]};
#pragma unroll
                for (int k = 0; k < 4; ++k) { const int r = row0 + t + k - 2; const float vm = (r >= s0 && r < s1) ? 1.0f : 0.0f; const u32x4 x = xv[i][k];
                    a[0] += vm * wq[k][0][0] * bflo(x.x); a[1] += vm * wq[k][0][1] * bfhi(x.x); a[2] += vm * wq[k][0][2] * bflo(x.y); a[3] += vm * wq[k][0][3] * bfhi(x.y);
                    a[4] += vm * wq[k][1][0] * bflo(x.z); a[5] += vm * wq[k][1][1] * bfhi(x.z); a[6] += vm * wq[k][1][2] * bflo(x.w); a[7] += vm * wq[k][1][3] * bfhi(x.w); }
                u32x4 o; o.x = pk2(a[0], a[1]); o.y = pk2(a[2], a[3]); o.z = pk2(a[4], a[5]); o.w = pk2(a[6], a[7]);
                *(LAS u32x4*)(ldsX + t * 272 + c8 * 16) = o; }
        }
        __syncthreads();
        f32x4 acc[8][4];
#pragma unroll
        for (int m = 0; m < 8; ++m)
#pragma unroll
            for (int n = 0; n < 4; ++n) acc[m][n] = (f32x4){0.f, 0.f, 0.f, 0.f};
        bf16x8 b[4], bn[4];
#pragma unroll
        for (int n = 0; n < 4; ++n) b[n] = *(const bf16x8*)(LW + ((size_t)(h * 512 + 64 * w + 16 * n + fr)) * 128 + 8 * fq);
#pragma unroll
        for (int ks = 0; ks < 4; ++ks) {
            if (ks < 3) {
#pragma unroll
                for (int n = 0; n < 4; ++n) bn[n] = *(const bf16x8*)(LW + ((size_t)(h * 512 + 64 * w + 16 * n + fr)) * 128 + 32 * (ks + 1) + 8 * fq); }
#pragma unroll
            for (int m = 0; m < 8; ++m) { const bf16x8 a = *(const LAS bf16x8*)(ldsX + (16 * m + fr) * 272 + ks * 64 + fq * 16);
#pragma unroll
                for (int n = 0; n < 4; ++n) acc[m][n] = __builtin_amdgcn_mfma_f32_16x16x32_bf16(b[n], a, acc[m][n], 0, 0, 0); }
            __builtin_amdgcn_sched_barrier(0);
#pragma unroll
            for (int n = 0; n < 4; ++n) b[n] = bn[n];
        }
#pragma unroll
        for (int m = 0; m < 8; ++m)
#pragma unroll
            for (int n = 0; n < 4; ++n) asm volatile("" : "+v"(acc[m][n]));
        asm volatile("" ::: "memory");
        const int ch = 128 * h + 16 * w + 4 * fq;
        f32x4 ba[2], bx[2], sp[2];
#pragma unroll
        for (int d = 0; d < 2; ++d) { const int co = d * 128 + 16 * w + 4 * fq; ba[d] = *(const LAS f32x4*)(prm + co); bx[d] = *(const LAS f32x4*)(prm + 256 + co); sp[d] = *(const LAS f32x4*)(prm + 512 + co); }
#pragma unroll
        for (int d = 0; d < 2; ++d) {
#pragma unroll
            for (int m = 0; m < 8; ++m) { const int t = 16 * m + fr; const size_t row = (size_t)(row0 + t);
                const u32x2 xw = *(const LAS u32x2*)(ldsX + t * 272 + (16 * w + 4 * fq) * 2); const float xc[4] = {bflo(xw.x), bfhi(xw.x), bflo(xw.y), bfhi(xw.y)};
                float la[4], bb[4];
#pragma unroll
                for (int r = 0; r < 4; ++r) { const float ra = sigmoidf_(acc[m][2 * d][r] + ba[d][r]), ii = sigmoidf_(acc[m][2 * d + 1][r] + bx[d][r]);
                    la[r] = -8.0f * ra * sp[d][r]; bb[r] = __builtin_amdgcn_sqrtf(fmaxf(1.0f - __builtin_amdgcn_exp2f(2.8853900817779268f * la[r]), 0.f)) * ii * xc[r]; }
                u32x2 ol, ob; ol.x = pk2(la[0], la[1]); ol.y = pk2(la[2], la[3]); *(u32x2*)(LA + ((size_t)d * MT + row) * 1024 + ch) = ol;
                ob.x = pk2(bb[0], bb[1]); ob.y = pk2(bb[2], bb[3]); *(u32x2*)(BB + ((size_t)d * MT + row) * 1024 + ch) = ob;
                u32x4 st; st.x = (ol.x & 0xffffu) | (ob.x << 16); st.y = (ol.x >> 16) | (ob.x & 0xffff0000u); st.z = (ol.y & 0xffffu) | (ob.y << 16); st.w = (ol.y >> 16) | (ob.y & 0xffff0000u);
                *(LAS u32x4*)(stg + t * 132 + 16 * w + 4 * fq) = st; }
            __syncthreads();
            { const int hf = tid >> 8, ck = (tid >> 7) & 1, cl = tid & 127; const LAS unsigned* sp_ = stg + (64 * ck) * 132 + cl;
                float s = 0.f, hh = 0.f;
#pragma unroll 8
                for (int i = 0; i < 32; ++i) { const int ii = 32 * hf + i; const unsigned v = sp_[(d ? 63 - ii : ii) * 132]; const float l = bflo(v); s += l; hh = fexp_(l) * hh + bfhi(v); }
                if (hf) hx[tid - 256] = (f32x2){s, hh};
                __syncthreads();
                if (!hf) { const f32x2 o = hx[tid]; *(f32x2*)(AGG + (((size_t)d * 520 + (size_t)(2 * rt + ck)) * 1024 + 128 * h + cl) * 2) = (f32x2){s + o[0], fexp_(o[0]) * hh + o[1]}; } }
        }
    }
}
__device__ __forceinline__ void lru_agg_phase(const Frame& F0) {
    Frame F = F0; F.tid = fresh_tid_w(F0.wave); F.lane = F.tid & 63;
    unsigned char* ws = F.ws; const bf16_t* LA = (const bf16_t*)(ws + WS_BIG + LRU_LA); const bf16_t* BB = (const bf16_t*)(ws + WS_BIG + LRU_BB); float* AGG = (float*)(ws + WS_AGG);
    for (int unit = F.vcu; unit < 520 * 2; unit += F.G) { const int cidx = unit >> 1, d = unit & 1; const size_t base = ((size_t)d * MT + (size_t)cidx * 64) * 1024 + 2 * F.tid;
        float s0 = 0.f, s1 = 0.f, h0 = 0.f, h1 = 0.f;
#pragma unroll 8
        for (int i = 0; i < 64; ++i) { const int t = d ? 63 - i : i; const unsigned lw = *(const unsigned*)(LA + base + (size_t)t * 1024), bw = *(const unsigned*)(BB + base + (size_t)t * 1024);
            const float l0 = bflo(lw), l1 = bfhi(lw); s0 += l0; s1 += l1; h0 = fexp_(l0) * h0 + bflo(bw); h1 = fexp_(l1) * h1 + bfhi(bw); }
        *(f32x4*)(AGG + (((size_t)d * 520 + cidx) * 1024 + 2 * F.tid) * 2) = (f32x4){s0, h0, s1, h1}; }
}
__device__ __forceinline__ void lru_carry_phase(const Frame& F0) {
    Frame F = F0; F.tid = fresh_tid_w(F0.wave); F.lane = F.tid & 63;
    unsigned char* ws = F.ws; const float* AGG = (const float*)(ws + WS_AGG); float* CARRY = (float*)(ws + WS_CARRY);
    LAS float* segS = (LAS float*)F.lds; LAS float* segH = segS + 512;
    for (int blk = F.vcu; blk < 128; blk += F.G) { const int cl = F.tid & 31, seg = F.tid >> 5, chain = blk * 32 + cl, b = chain >> 11, d = (chain >> 10) & 1, ch = chain & 1023;
        f32x2 ag[16], cx[4];
#pragma unroll
        for (int k = 0; k < 16; ++k) { const int i = seg * 16 + k, cidx = 256 * b + (d ? 255 - i : i); ag[k] = *(const f32x2*)(AGG + (((size_t)d * 520 + cidx) * 1024 + ch) * 2); }
#pragma unroll
        for (int i = 0; i < 4; ++i) { const int cidx = 512 + 4 * b + (d ? 3 - i : i); cx[i] = *(const f32x2*)(AGG + (((size_t)d * 520 + cidx) * 1024 + ch) * 2); }
        asm volatile("" ::: "memory");
        float S = 0.f, H = 0.f;
#pragma unroll
        for (int k = 0; k < 16; ++k) { S += ag[k][0]; H = fexp_(ag[k][0]) * H + ag[k][1]; }
        segS[seg * 32 + cl] = S; segH[seg * 32 + cl] = H;
        __syncthreads();
        float h = 0.f;
#pragma unroll
        for (int i = 0; i < 4; ++i) h = fexp_(cx[i][0]) * h + cx[i][1];
        for (int s2 = 0; s2 < seg; ++s2) h = fexp_(segS[s2 * 32 + cl]) * h + segH[s2 * 32 + cl];
#pragma unroll
        for (int k = 0; k < 16; ++k) { const int i = seg * 16 + k, cidx = 256 * b + (d ? 255 - i : i); CARRY[((size_t)d * 512 + cidx) * 1024 + ch] = h; h = fexp_(ag[k][0]) * h + ag[k][1]; }
        __syncthreads();
    }
}
#define SCAN_LD(dst_, base_, imm_) asm volatile("s_nop 4\n\tglobal_load_dword %0, %1, %2 offset:" #imm_ : "=v"(dst_) : "v"(voff), "s"(base_))
#define SCAN_LD32(arr_, base_, t0_) do { _Pragma("unroll") for (int t_ = 0; t_ < 32; t_ += 2) { const char* p_ = (base_) + (size_t)((t0_) + t_) * 2048; SCAN_LD(arr_[t_], p_, 0); SCAN_LD(arr_[t_ + 1], p_, 2048); } } while (0)
#define SCAN_LDG32(arr_, base_, t0_) do { _Pragma("unroll") for (int t_ = 0; t_ < 32; ++t_) { const char* p_ = (base_) + (size_t)((t0_) + t_) * 4096; SCAN_LD(arr_[t_], p_, 0); } } while (0)
#define SCAN_PIN32(arr_) do { _Pragma("unroll") for (int t_ = 0; t_ < 32; ++t_) asm volatile("" : "+v"(arr_[t_])); } while (0)
__device__ __forceinline__ void lru_scan_phase(const Frame& F0) {
    Frame F = F0; F.tid = fresh_tid_w(F0.wave); F.lane = F.tid & 63;
    unsigned char* ws = F.ws; const char* GXc = (const char*)(ws + WS_BIG); const char* LAc = (const char*)(ws + WS_BIG + LRU_LA); const char* BBc = (const char*)(ws + WS_BIG + LRU_BB);
    const float* CARRY = (const float*)(ws + WS_CARRY); bf16_t* S2 = (bf16_t*)(ws + WS_H);
    LAS f32x2* hfl = (LAS f32x2*)F.lds;
    const unsigned voff = 4u * (unsigned)F.tid; const size_t bo = (size_t)MT * 2048;
    for (int unit = F.vcu; unit < 512; unit += F.G) { const int cidx = unit; const size_t row0 = (size_t)cidx * 64; const int c2 = 2 * F.tid;
        const char* laF = LAc + row0 * 2048; const char* bbF = BBc + row0 * 2048; const char* laB = laF + bo; const char* bbB = bbF + bo; const char* gx = GXc + row0 * 4096;
        unsigned lw[32], bw[32], gw[32], bw2[32];
        SCAN_LD32(lw, laF, 0); SCAN_LD32(bw, bbF, 0); SCAN_LD32(gw, laF, 32); SCAN_LD32(bw2, bbF, 32);
        const f32x2 cf = *(const f32x2*)(CARRY + ((size_t)0 * 512 + cidx) * 1024 + c2), cb = *(const f32x2*)(CARRY + ((size_t)1 * 512 + cidx) * 1024 + c2);
        asm volatile("s_waitcnt vmcnt(0)" ::: "memory"); SCAN_PIN32(lw); SCAN_PIN32(bw); SCAN_PIN32(gw); SCAN_PIN32(bw2);
        float h0 = cf[0], h1 = cf[1];
#pragma unroll
        for (int t = 0; t < 32; ++t) { h0 = fexp_(bflo(lw[t])) * h0 + bflo(bw[t]); h1 = fexp_(bfhi(lw[t])) * h1 + bfhi(bw[t]); hfl[t * 512 + F.tid] = (f32x2){h0, h1}; }
        f32x2 hf2[32];
#pragma unroll
        for (int t = 0; t < 32; ++t) { h0 = fexp_(bflo(gw[t])) * h0 + bflo(bw2[t]); h1 = fexp_(bfhi(gw[t])) * h1 + bfhi(bw2[t]); hf2[t] = (f32x2){h0, h1}; }
        SCAN_LD32(lw, laB, 32); SCAN_LD32(bw, bbB, 32); SCAN_LDG32(gw, gx, 32);
        asm volatile("s_waitcnt vmcnt(0)" ::: "memory"); SCAN_PIN32(lw); SCAN_PIN32(bw); SCAN_PIN32(gw);
        float g0 = cb[0], g1 = cb[1];
#pragma unroll
        for (int t = 31; t >= 0; --t) { const size_t r = row0 + 32 + t;
            g0 = fexp_(bflo(lw[t])) * g0 + bflo(bw[t]); g1 = fexp_(bfhi(lw[t])) * g1 + bfhi(bw[t]);
            *(unsigned*)(S2 + r * 1024 + c2) = pk2(bflo(gw[t]) * (hf2[t][0] + g0), bfhi(gw[t]) * (hf2[t][1] + g1)); }
        SCAN_LD32(lw, laB, 0); SCAN_LD32(bw, bbB, 0); SCAN_LDG32(gw, gx, 0);
        asm volatile("s_waitcnt vmcnt(0)" ::: "memory"); SCAN_PIN32(lw); SCAN_PIN32(bw); SCAN_PIN32(gw);
#pragma unroll
        for (int t = 31; t >= 0; --t) { const size_t r = row0 + t;
            g0 = fexp_(bflo(lw[t])) * g0 + bflo(bw[t]); g1 = fexp_(bfhi(lw[t])) * g1 + bfhi(bw[t]);
            const f32x2 hf = hfl[t * 512 + F.tid];
            *(unsigned*)(S2 + r * 1024 + c2) = pk2(bflo(gw[t]) * (hf[0] + g0), bfhi(gw[t]) * (hf[1] + g1)); }
    }
}

__device__ __forceinline__ void moe_index_phase(const Frame& F0) {
    Frame F = F0; F.tid = fresh_tid_w(F0.wave); F.lane = F.tid & 63;
    unsigned char* ws = F.ws; const int tid = F.tid, lane = F.lane;
    int* counts = (int*)(ws + WS_COUNTS); int* tile_exp = counts + 4096; int* ntiles_p = counts + 5120; unsigned* route = (unsigned*)(ws + WS_ROUTE);
    const unsigned char* H8 = ws + WS_H; unsigned char* AS8 = ws + WS_BIG;
    LAS int* lc = (LAS int*)F.lds;
    LAS int* tot = lc + 2048; LAS int* pre = tot + 8; LAS int* seg = pre + 8; LAS unsigned* e01 = (LAS unsigned*)(seg + 16); LAS int* pos = (LAS int*)(e01 + 128);
    for (int blk = F.vcu; blk < 256; blk += F.G) {
        u32x4 o[16];
#pragma unroll
        for (int i = 0; i < 16; ++i) { const size_t m = (size_t)blk * 128 + F.wave * 16 + i; o[i] = *(const u32x4*)(H8 + m * 1024 + 16 * lane); }
        { const int e = F.wave; int t = 0, pz = 0;
#pragma unroll
            for (int jj = 0; jj < 4; ++jj) { const int b = 4 * lane + jj; const int c = counts[b * 8 + e]; t += c; pz += (b < blk) ? c : 0; }
#pragma unroll
            for (int o = 1; o < 64; o <<= 1) { t += __shfl_xor(t, o); pz += __shfl_xor(pz, o); }
            if (lane == 0) { tot[e] = t; pre[e] = pz; } }
        __syncthreads();
        if (tid == 0) { int s = 0; for (int e = 0; e < 8; ++e) { seg[e] = s; s += ((tot[e] + 255) >> 8) << 8; } seg[8] = s;
            if (blk == 0) { *ntiles_p = s >> 8; for (int e = 0; e < 8; ++e) for (int pm = seg[e] >> 8; pm < (seg[e + 1] >> 8); ++pm) tile_exp[pm] = e; } }
        __syncthreads();
        { const int e = F.wave; int base = seg[e] + pre[e];
#pragma unroll
            for (int ps = 0; ps < 2; ++ps) { const int i = lane + 64 * ps; const unsigned wv = route[(size_t)(blk * 128 + i) * 8]; const bool m0 = (int)(wv & 255u) == e, m1 = (int)((wv >> 8) & 255u) == e;
                const unsigned long long bal = __ballot(m0 || m1); const int rank = (int)__builtin_amdgcn_mbcnt_hi((unsigned)(bal >> 32), __builtin_amdgcn_mbcnt_lo((unsigned)bal, 0u));
                if (m0) pos[2 * i] = base + rank; if (m1) pos[2 * i + 1] = base + rank;
                base += __builtin_popcountll(bal); } }
        __syncthreads();
        if (tid < 128) { route[(size_t)(blk * 128 + tid) * 8 + 3] = (unsigned)pos[2 * tid]; route[(size_t)(blk * 128 + tid) * 8 + 4] = (unsigned)pos[2 * tid + 1]; }
        {
#pragma unroll
            for (int i = 0; i < 16; ++i) { const int tl = F.wave * 16 + i; const int p0 = pos[2 * tl], p1 = pos[2 * tl + 1];
                *(u32x4*)(AS8 + (size_t)p0 * 1024 + 16 * lane) = o[i]; *(u32x4*)(AS8 + (size_t)p1 * 1024 + 16 * lane) = o[i]; } }
        __syncthreads();
    }
}
constexpr size_t HY_YP = 0, HY_KS = 64 * MiB, HY_Y1 = 128 * MiB, HY_XP = 192 * MiB;
__device__ __forceinline__ int seg_lds(int chl, int n0) { return (chl * 32 + n0) * 17 + ((chl >> 3) << 3); }

__device__ __forceinline__ void hy_pack_phase(const Frame& F0) {
    Frame F = F0; F.tid = fresh_tid_w(F0.wave); F.lane = F.tid & 63;
    const Params& P = *F.P; unsigned char* ws = F.ws; const int tid = F.tid;
    const bf16_t* Z = (const bf16_t*)(ws + WS_BIG); unsigned* XP = (unsigned*)(ws + WS_BIG + HY_XP);
    LAS unsigned char* L8 = F.lds; LAS unsigned* L32 = (LAS unsigned*)F.lds;
    for (int unit = F.vcu; unit < 3 * 16 * 32; unit += F.G) {
        const int n1 = unit & 31, cb = (unit >> 5) & 15, part = unit >> 9; const int chbase = part * 1024 + cb * 64;
        { const int c8 = tid & 7, n0 = (tid >> 3) & 31, r0 = tid >> 8, ch0 = chbase + 8 * c8;
            f32x4 wq[3][2], bq[2]; bq[0] = *(const f32x4*)(P.in[I_HCB] + ch0); bq[1] = *(const f32x4*)(P.in[I_HCB] + ch0 + 4);
#pragma unroll
            for (int k = 0; k < 3; ++k) { const float zs = HIN8 ? 1.0f / (float)(1 << (FFN_SA1 + FFN_SB1)) : 1.0f;
                wq[k][0] = *(const f32x4*)(P.in[I_HCW] + k * 3072 + ch0) * zs; wq[k][1] = *(const f32x4*)(P.in[I_HCW] + k * 3072 + ch0 + 4) * zs; }
#pragma unroll 1
            for (int g = 0; g < 4; ++g) {
                u32x4 xv[4][3];
#pragma unroll
                for (int j = 0; j < 4; ++j) { const int rest = r0 + 2 * (4 * g + j), n2 = rest & 15, b = rest >> 4, t = n0 + 32 * n1 + 1024 * n2;
#pragma unroll
                    for (int k = 0; k < 3; ++k) { int tt = t + k - 1; tt = tt < 0 ? 0 : (tt > SEQ - 1 ? SEQ - 1 : tt); xv[j][k] = *(const u32x4*)(Z + ((size_t)b * SEQ + tt) * 3072 + ch0); } }
                asm volatile("" ::: "memory");
#pragma unroll
                for (int j = 0; j < 4; ++j) { const int rest = r0 + 2 * (4 * g + j), n2 = rest & 15, b = rest >> 4, t = n0 + 32 * n1 + 1024 * n2;
                    float a[8] = {bq[0][0], bq[0][1], bq[0][2], bq[0][3], bq[1][0], bq[1][1], bq[1][2], bq[1][3]};
#pragma unroll
                    for (int k = 0; k < 3; ++k) { const int tt = t + k - 1; const float vm = (tt >= 0 && tt < SEQ) ? 1.0f : 0.0f; const u32x4 x = xv[j][k];
                        a[0] += vm * wq[k][0][0] * bflo(x.x); a[1] += vm * wq[k][0][1] * bfhi(x.x); a[2] += vm * wq[k][0][2] * bflo(x.y); a[3] += vm * wq[k][0][3] * bfhi(x.y);
                        a[4] += vm * wq[k][1][0] * bflo(x.z); a[5] += vm * wq[k][1][1] * bfhi(x.z); a[6] += vm * wq[k][1][2] * bflo(x.w); a[7] += vm * wq[k][1][3] * bfhi(x.w); }
#pragma unroll
                    for (int k = 0; k < 8; ++k) *(LAS bf16_t*)(L8 + (seg_lds(8 * c8 + k, n0) + n2) * 4 + 2 * b) = (bf16_t)f2bf(a[k]); }
            }
        }
        __syncthreads();
#pragma unroll 4
        for (int i = 0; i < 16; ++i) { const int idx = tid + 512 * i, qd = idx & 3, seg = idx >> 2, chl = seg >> 5, n0 = seg & 31; const int so = seg_lds(chl, n0) + 4 * qd;
            u32x4 o; o.x = L32[so]; o.y = L32[so + 1]; o.z = L32[so + 2]; o.w = L32[so + 3];
            *(u32x4*)(XP + ((size_t)(chbase + chl) * SEQ + (size_t)(n0 * 32 + n1) * 16 + 4 * qd)) = o; }
        __syncthreads();
    }
}
__device__ __forceinline__ void hy_unpack_phase(const Frame& F0) {
    Frame F = F0; F.tid = fresh_tid_w(F0.wave); F.lane = F.tid & 63;
    unsigned char* ws = F.ws; const int tid = F.tid;
    const unsigned* YP = (const unsigned*)(ws + WS_BIG + HY_YP); bf16_t* YT = (bf16_t*)(ws + WS_H);
    LAS unsigned char* L8 = F.lds; LAS unsigned* L32 = (LAS unsigned*)F.lds;
    for (int unit = F.vcu; unit < 16 * 32; unit += F.G) {
        const int n1 = unit & 31, cb = unit >> 5; const int chbase = cb * 64;
        { u32x4 v[16];
#pragma unroll
            for (int i = 0; i < 16; ++i) { const int idx = tid + 512 * i, qd = idx & 3, seg = idx >> 2, chl = seg >> 5, n0 = seg & 31;
                v[i] = *(const u32x4*)(YP + ((size_t)(chbase + chl) * SEQ + (size_t)(n0 * 32 + n1) * 16 + 4 * qd)); }
            asm volatile("" ::: "memory");
#pragma unroll
            for (int i = 0; i < 16; ++i) { const int idx = tid + 512 * i, qd = idx & 3, seg = idx >> 2, chl = seg >> 5, n0 = seg & 31; const int so = seg_lds(chl, n0) + 4 * qd;
                L32[so] = v[i].x; L32[so + 1] = v[i].y; L32[so + 2] = v[i].z; L32[so + 3] = v[i].w; } }
        __syncthreads();
#pragma unroll 4
        for (int i = 0; i < 16; ++i) { const int idx = tid + 512 * i, c8 = idx & 7, n0 = (idx >> 3) & 31, rest = idx >> 8, n2 = rest & 15, b = rest >> 4;
            const int t = n0 + 32 * n1 + 1024 * n2; const size_t row = (size_t)b * SEQ + t;
            unsigned hv[8];
#pragma unroll
            for (int k = 0; k < 8; ++k) hv[k] = *(const LAS bf16_t*)(L8 + (seg_lds(8 * c8 + k, n0) + n2) * 4 + 2 * b);
            u32x4 o; o.x = hv[0] | (hv[1] << 16); o.y = hv[2] | (hv[3] << 16); o.z = hv[4] | (hv[5] << 16); o.w = hv[6] | (hv[7] << 16);
            *(u32x4*)(YT + row * 1024 + chbase + 8 * c8) = o; }
        __syncthreads();
    }
}

__device__ __forceinline__ int xaddr(int x, int y, int z) { return x * 1152 + y * 36 + z; }

struct FftCtx {
    bf16x8 afr[2][4];
    bf16x8 invmask;
    const LAS float* twl;
};
__device__ __forceinline__ void fft_ctx_init(FftCtx& C, int lane, int wave, LAS float* twl) {
    const int i = lane & 31, h = lane >> 5, pp = i & 1;
#pragma unroll
    for (int rb = 0; rb < 2; ++rb)
#pragma unroll
        for (int s = 0; s < 4; ++s) { const int zp = 16 * rb + (i >> 1);
#pragma unroll
            for (int e = 0; e < 8; ++e) { const int z = 8 * s + 4 * h + (e >> 1), p = e & 1; const float th = -6.283185307179586f * (float)((z * zp) & 31) * (1.0f / 32.0f);
                const float fr = __cosf(th), fi = __sinf(th); const float v = (pp == p) ? fr : (pp == 0 ? -fi : fi);
                C.afr[rb][s][e] = (short)f2bf(v); } }
#pragma unroll
    for (int e = 0; e < 8; ++e) C.invmask[e] = (short)(((e & 1) != pp) ? 0x8000 : 0);
#pragma unroll
    for (int rb = 0; rb < 2; ++rb)
#pragma unroll
        for (int g = 0; g < 4; ++g)
#pragma unroll
            for (int e = 0; e < 2; ++e) { const int zp = 16 * rb + 4 * g + 2 * h + e; const float th = -6.283185307179586f * (float)((i * zp) & 1023) * (1.0f / 1024.0f);
                if (wave == 0) *(LAS f32x2*)(twl + lane * 36 + 2 * (rb * 8 + g * 2 + e)) = (f32x2){__cosf(th), __sinf(th)}; }
    C.twl = twl + lane * 36;
}
template <int NS>
__device__ __forceinline__ void fft_read(const LAS unsigned* X, int x, int lane, bf16x8 (&b)[4]) {
    const int j = lane & 31, h = lane >> 5;
#pragma unroll
    for (int s = 0; s < NS; ++s) b[s] = *(const LAS bf16x8*)(X + x * 1152 + j * 36 + 4 * (2 * s + h));
}
template <int NS, int NRB, bool INV>
__device__ __forceinline__ void fft_mma(const FftCtx& C, const bf16x8 (&b)[4], f32x16 (&acc)[2]) {
#pragma unroll
    for (int rb = 0; rb < NRB; ++rb) {
#pragma unroll
        for (int r = 0; r < 16; ++r) acc[rb][r] = 0.f;
#pragma unroll
        for (int s = 0; s < NS; ++s) { const bf16x8 a = INV ? (bf16x8)(C.afr[rb][s] ^ C.invmask) : C.afr[rb][s]; acc[rb] = __builtin_amdgcn_mfma_f32_32x32x16_bf16(a, b[s], acc[rb], 0, 0, 0); } }
}
template <int NRB, bool INV, int TW>
__device__ __forceinline__ void fft_twiddle(const FftCtx& C, f32x16 (&acc)[2], int x, int lane) {
    if (TW == 0) return;
    float ur = 1.f, ui = 0.f;
    if (TW == 2) { const int j = lane & 31; const float th = -6.283185307179586f * (float)(j * x) * (1.0f / 32768.0f); ur = __cosf(th); ui = __sinf(th); }
#pragma unroll
    for (int rb = 0; rb < NRB; ++rb)
#pragma unroll
        for (int g = 0; g < 4; ++g)
#pragma unroll
            for (int e = 0; e < 2; ++e) { const f32x2 twv = *(const LAS f32x2*)(C.twl + 2 * (rb * 8 + g * 2 + e)); float wr = twv[0], wi = twv[1];
                if (TW == 2) { const float a = wr * ur - wi * ui, b = wr * ui + wi * ur; wr = a; wi = b; }
                if (INV) wi = -wi;
                const float re = acc[rb][4 * g + 2 * e], im = acc[rb][4 * g + 2 * e + 1];
                acc[rb][4 * g + 2 * e] = re * wr - im * wi; acc[rb][4 * g + 2 * e + 1] = re * wi + im * wr; }
}
template <int NRB, int MODE>
__device__ __forceinline__ void fft_write(LAS unsigned* X, const f32x16 (&acc)[2], int x, int lane) {
    const int j = lane & 31, h = lane >> 5;
    int base = (MODE == 0) ? xaddr(2 * h, x, j) : (MODE == 1) ? xaddr(x, 2 * h, j) : xaddr(x, j, 2 * h);
    asm volatile("" : "+v"(base));
    LAS unsigned* Xb = X + base;
#pragma unroll
    for (int rb = 0; rb < NRB; ++rb)
#pragma unroll
        for (int g = 0; g < 4; ++g) { const int zc = 16 * rb + 4 * g;
            const unsigned v0 = pk2(acc[rb][4 * g], acc[rb][4 * g + 1]), v1 = pk2(acc[rb][4 * g + 2], acc[rb][4 * g + 3]);
            if (MODE == 0) { Xb[zc * 1152] = v0; Xb[(zc + 1) * 1152] = v1; }
            else if (MODE == 1) { Xb[zc * 36] = v0; Xb[(zc + 1) * 36] = v1; }
            else { *(LAS u32x2*)(Xb + zc) = (u32x2){v0, v1}; } }
}
template <int NS, int NRB, bool INV, int TW, int MODE>
__device__ __forceinline__ void fft_stage_local(const FftCtx& C, LAS unsigned* X, int wave, int lane) {
#pragma unroll 1
    for (int i = 0; i < 4; ++i) { const int x = 4 * wave + i; bf16x8 b[4]; f32x16 acc[2];
        fft_read<NS>(X, x, lane, b); fft_mma<NS, NRB, INV>(C, b, acc); fft_twiddle<NRB, INV, TW>(C, acc, x, lane); fft_write<NRB, MODE>(X, acc, x, lane); }
}
template <int NS, bool INV>
__device__ __forceinline__ void fft_stage_global(const FftCtx& C, LAS unsigned* X, int wave, int lane) {
    bf16x8 b[4][4];
#pragma unroll
    for (int i = 0; i < 4; ++i) fft_read<NS>(X, 4 * wave + i, lane, b[i]);
    LDS_WAIT(); __syncthreads();
#pragma unroll
    for (int i = 0; i < 4; ++i) { const int x = 4 * wave + i; f32x16 acc[2];
        fft_mma<NS, 2, INV>(C, b[i], acc); fft_twiddle<2, INV, 1>(C, acc, x, lane); fft_write<2, 0>(X, acc, x, lane); __builtin_amdgcn_sched_barrier(0); }
    LDS_WAIT(); __syncthreads();
}

__device__ __forceinline__ void hy_fft_phase(const Frame& F0) {
    Frame F = F0; F.tid = fresh_tid_w(F0.wave); F.lane = F.tid & 63;
    const Params& P = *F.P; unsigned char* ws = F.ws; const int tid = F.tid, lane = F.lane, wave = F.wave, j = lane & 31, h = lane >> 5;
    LAS unsigned* X = (LAS unsigned*)F.lds;
    const bf16_t* KP = (const bf16_t*)(ws + WS_Y); const unsigned* XP = (const unsigned*)(ws + WS_BIG + HY_XP); unsigned* YP = (unsigned*)(ws + WS_BIG + HY_YP);
    u32x2* KS = (u32x2*)(ws + WS_BIG + HY_KS) + (size_t)blockIdx.x * 32768; u32x2* Y1 = (u32x2*)(ws + WS_BIG + HY_Y1) + (size_t)blockIdx.x * 8192;
    FftCtx C; fft_ctx_init(C, lane, wave, (LAS float*)(F.lds + 147712)); __syncthreads();
    for (int ch = F.vcu; ch < 1024; ch += F.G) {
#ifdef FFT_REP_FILT
        for (int rep_ = 0; rep_ < 2; ++rep_)
#endif
        {
            const bf16_t* kpa = KP + (size_t)ch * 32768; const bf16_t* kpb = KP + (size_t)(1024 + ch) * 32768;
            u32x4 fa[4][2], fb[4][2];
#pragma unroll
            for (int i = 0; i < 4; ++i) { const int x = 4 * wave + i; const size_t eo = (size_t)(x * 32 + j) * 32 + 16 * h;
                fa[i][0] = *(const u32x4*)(kpa + eo); fa[i][1] = *(const u32x4*)(kpa + eo + 8); fb[i][0] = *(const u32x4*)(kpb + eo); fb[i][1] = *(const u32x4*)(kpb + eo + 8); }
            asm volatile("" ::: "memory");
#pragma unroll
            for (int i = 0; i < 4; ++i) { const int x = 4 * wave + i;
                const unsigned wa[8] = {fa[i][0].x, fa[i][0].y, fa[i][0].z, fa[i][0].w, fa[i][1].x, fa[i][1].y, fa[i][1].z, fa[i][1].w};
                const unsigned wb[8] = {fb[i][0].x, fb[i][0].y, fb[i][0].z, fb[i][0].w, fb[i][1].x, fb[i][1].y, fb[i][1].z, fb[i][1].w};
#pragma unroll
                for (int c = 0; c < 4; ++c) { u32x4 o4; o4.x = (wa[2 * c] & 0xffffu) | (wb[2 * c] << 16); o4.y = (wa[2 * c] >> 16) | (wb[2 * c] & 0xffff0000u);
                    o4.z = (wa[2 * c + 1] & 0xffffu) | (wb[2 * c + 1] << 16); o4.w = (wa[2 * c + 1] >> 16) | (wb[2 * c + 1] & 0xffff0000u);
                    *(LAS u32x4*)(X + xaddr(x, j, 16 * h + 4 * c)) = o4; } }
            fft_stage_global<4, false>(C, X, wave, lane);
            fft_stage_local<4, 2, false, 2, 1>(C, X, wave, lane);
#pragma unroll 1
            for (int i = 0; i < 4; ++i) { const int x = 4 * wave + i; bf16x8 b[4]; f32x16 acc[2]; fft_read<4>(X, x, lane, b); fft_mma<4, 2, false>(C, b, acc); fft_write<2, 2>(X, acc, x, lane); }
            LDS_WAIT(); __syncthreads();
#pragma unroll 1
            for (int i = 0; i < 4; ++i) { const int x = 4 * wave + i, xq = (32 - x) & 31, c1 = (x != 0) ? 1 : 0, jq = (-j - c1) & 31, b2 = (x != 0 || j != 0) ? 1 : 0;
                const LAS unsigned* own = X + xaddr(x, j, 2 * h); const LAS unsigned* pb = X + xaddr(xq, jq, 0); const float hs = 0.5f / 32768.0f;
#pragma unroll
                for (int rb = 0; rb < 2; ++rb)
#pragma unroll
                    for (int g = 0; g < 4; ++g) { const u32x2 ow = *(const LAS u32x2*)(own + 16 * rb + 4 * g); unsigned k0w[2], k1w[2];
#pragma unroll
                        for (int e = 0; e < 2; ++e) { const int zz = 16 * rb + 4 * g + 2 * h + e, zq = (-zz - b2) & 31; const unsigned pw = pb[zq], zw = e ? ow.y : ow.x;
                            const float zr = bflo(zw), zi = bfhi(zw), pr = bflo(pw), pi = bfhi(pw);
                            k0w[e] = pk2(hs * (zr + pr), hs * (zi - pi)); k1w[e] = pk2(hs * (zi + pi), hs * (pr - zr)); }
                        KS[(size_t)((0 * 4 + i) * 8 + rb * 4 + g) * 512 + tid] = (u32x2){k0w[0], k0w[1]}; KS[(size_t)((1 * 4 + i) * 8 + rb * 4 + g) * 512 + tid] = (u32x2){k1w[0], k1w[1]}; } }
            LDS_WAIT(); __syncthreads();
        }
        const unsigned* vp = XP + (size_t)(2 * 1024 + ch) * SEQ;
        { u32x4 sv[4][2];
#pragma unroll
            for (int i = 0; i < 4; ++i) { const int x = 4 * wave + i; sv[i][0] = *(const u32x4*)(vp + (x * 32 + j) * 16 + 8 * h); sv[i][1] = *(const u32x4*)(vp + (x * 32 + j) * 16 + 8 * h + 4); }
            asm volatile("" ::: "memory");
#pragma unroll
            for (int i = 0; i < 4; ++i) { const int x = 4 * wave + i; *(LAS u32x4*)(X + xaddr(x, j, 8 * h)) = sv[i][0]; *(LAS u32x4*)(X + xaddr(x, j, 8 * h + 4)) = sv[i][1]; } }
#pragma unroll 1
        for (int o = 0; o < 2; ++o) {
            const float bias = P.in[I_HBIAS][o * 1024 + ch];
            const unsigned* gp = XP + (size_t)(o * 1024 + ch) * SEQ;
            fft_stage_global<2, false>(C, X, wave, lane);
            fft_stage_local<4, 2, false, 2, 1>(C, X, wave, lane);
            u32x2 kq[8];
#pragma unroll
            for (int q = 0; q < 8; ++q) kq[q] = KS[(size_t)((o * 4) * 8 + q) * 512 + tid];
#pragma unroll 1
            for (int i = 0; i < 4; ++i) { const int x = 4 * wave + i; bf16x8 b[4]; f32x16 acc[2]; u32x2 kc[8];
#pragma unroll
                for (int q = 0; q < 8; ++q) kc[q] = kq[q];
                if (i < 3) {
#pragma unroll
                    for (int q = 0; q < 8; ++q) kq[q] = KS[(size_t)((o * 4 + i + 1) * 8 + q) * 512 + tid]; }
                asm volatile("" ::: "memory");
                fft_read<4>(X, x, lane, b); fft_mma<4, 2, false>(C, b, acc);
#pragma unroll
                for (int rb = 0; rb < 2; ++rb)
#pragma unroll
                    for (int g = 0; g < 4; ++g) { const u32x2 kw = kc[rb * 4 + g];
                        { const float kr = bflo(kw.x), ki = bfhi(kw.x), re = acc[rb][4 * g], im = acc[rb][4 * g + 1]; acc[rb][4 * g] = re * kr - im * ki; acc[rb][4 * g + 1] = re * ki + im * kr; }
                        { const float kr = bflo(kw.y), ki = bfhi(kw.y), re = acc[rb][4 * g + 2], im = acc[rb][4 * g + 3]; acc[rb][4 * g + 2] = re * kr - im * ki; acc[rb][4 * g + 3] = re * ki + im * kr; } }
                fft_write<2, 2>(X, acc, x, lane); }
            fft_stage_global<4, true>(C, X, wave, lane);
            fft_stage_local<4, 2, true, 2, 1>(C, X, wave, lane);
            u32x2 gq[4], uq[4];
#define HY_GU_ISSUE(i_) do { const size_t eo_ = (size_t)((4 * wave + (i_)) * 32 + j) * 16 + 2 * h; _Pragma("unroll") for (int g_ = 0; g_ < 4; ++g_) { gq[g_] = *(const u32x2*)(gp + eo_ + 4 * g_); \
                if (o == 0) uq[g_] = *(const u32x2*)(vp + eo_ + 4 * g_); else uq[g_] = Y1[(size_t)((i_) * 4 + g_) * 512 + tid]; } } while (0)
            HY_GU_ISSUE(0);
#pragma unroll 1
            for (int i = 0; i < 4; ++i) { const int x = 4 * wave + i; bf16x8 b[4]; f32x16 acc[2]; u32x2 gc[4], uc[4];
#pragma unroll
                for (int g = 0; g < 4; ++g) { gc[g] = gq[g]; uc[g] = uq[g]; }
                if (i < 3) HY_GU_ISSUE(i + 1);
                asm volatile("" ::: "memory");
                fft_read<4>(X, x, lane, b); fft_mma<4, 1, true>(C, b, acc);
                const size_t eo = (size_t)(x * 32 + j) * 16 + 2 * h;
#pragma unroll
                for (int g = 0; g < 4; ++g) { const u32x2 gt = gc[g];
                    const u32x2 uu = uc[g];
                    const float y00 = bflo(gt.x) * (acc[0][4 * g] + bias * bflo(uu.x)), y01 = bfhi(gt.x) * (acc[0][4 * g + 1] + bias * bfhi(uu.x));
                    const float y10 = bflo(gt.y) * (acc[0][4 * g + 2] + bias * bflo(uu.y)), y11 = bfhi(gt.y) * (acc[0][4 * g + 3] + bias * bfhi(uu.y));
                    const u32x2 ov = (u32x2){pk2(y00, y01), pk2(y10, y11)};
                    if (o == 0) { Y1[(size_t)(i * 4 + g) * 512 + tid] = ov; *(LAS u32x2*)(X + xaddr(x, j, 4 * g + 2 * h)) = ov; }
                    else *(u32x2*)(YP + (size_t)ch * SEQ + eo + 4 * g) = ov; } }
        }
    }
}
__device__ __forceinline__ void pool_phase(const Frame& F0) {
    Frame F = F0; F.tid = fresh_tid_w(F0.wave); F.lane = F.tid & 63;
    const Params& P = *F.P; unsigned char* ws = F.ws; const int tid = F.tid, lane = F.lane, w = F.wave, fr = lane & 15, fq = lane >> 4;
    const bf16_t* PB = (const bf16_t*)(ws + WS_BIG); bf16_t* A2 = (bf16_t*)(ws + WS_BIG + 64 * MiB); const bf16_t* PW = (const bf16_t*)(ws + WS_POOLW);
    LAS unsigned char* ldsP = F.lds;
    LAS unsigned char* ldsQ = F.lds + 76032;
    for (int unit = F.vcu; unit < (ML / 128) * 4; unit += F.G) {
        const int tile = unit >> 2, g = unit & 3, row0 = tile * 128, s0 = (row0 >> 14) << 14, t0 = row0 - s0, half = 1 << g;
        bf16x8 bw[8][2]; f32x4 bgq[2], scq[2];
        { u32x4 v[9];
#pragma unroll
            for (int i = 0; i < 9; ++i) { const int idx = tid + 512 * i, rr = idx >> 5, c8 = idx & 31; int t = t0 - 8 + rr; t = t < 0 ? 0 : (t > SEQ - 1 ? SEQ - 1 : t);
                v[i] = *(const u32x4*)(PB + (size_t)(s0 + t) * 1024 + 256 * g + 8 * c8); }
#pragma unroll
            for (int ks = 0; ks < 8; ++ks)
#pragma unroll
                for (int n = 0; n < 2; ++n) bw[ks][n] = *(const bf16x8*)(PW + ((size_t)(g * 256 + 32 * w + 16 * n + fr)) * 256 + 32 * ks + 8 * fq);
#pragma unroll
            for (int n = 0; n < 2; ++n) { const int d = 32 * w + 16 * n + 4 * fq; bgq[n] = *(const f32x4*)(P.in[I_PBG] + g * 256 + d); scq[n] = *(const f32x4*)(P.in[I_PSCALE] + g * 256 + d); }
            asm volatile("" ::: "memory");
#pragma unroll
            for (int i = 0; i < 9; ++i) { const int idx = tid + 512 * i, rr = idx >> 5, c8 = idx & 31; const int t = t0 - 8 + rr;
                u32x4 o = v[i]; if (t < 0 || t >= SEQ) o = (u32x4){0u, 0u, 0u, 0u};
                *(LAS u32x4*)(ldsP + rr * 528 + c8 * 16) = o; } }
        __syncthreads();
#pragma unroll 1
        for (int i = 0; i < 8; ++i) { const int idx = tid + 512 * i, tl = idx >> 5, c8 = idx & 31; const int t = t0 + tl;
            const int lo = (t - half) < 0 ? 0 : (t - half), hi = (t + half) > SEQ ? SEQ : (t + half); const float inv = 1.0f / (float)(hi - lo);
            float a[8];
#pragma unroll
            for (int k = 0; k < 8; ++k) a[k] = 0.f;
            for (int s = lo; s < hi; ++s) { const u32x4 v = *(const LAS u32x4*)(ldsP + (s - t0 + 8) * 528 + c8 * 16);
                a[0] += bflo(v.x); a[1] += bfhi(v.x); a[2] += bflo(v.y); a[3] += bfhi(v.y); a[4] += bflo(v.z); a[5] += bfhi(v.z); a[6] += bflo(v.w); a[7] += bfhi(v.w); }
            const u32x4 c = *(const LAS u32x4*)(ldsP + (tl + 8) * 528 + c8 * 16);
            const float zs = PIN8 ? 1.0f / (float)(1 << (FFN_SA1 + FFN_SB1)) : 1.0f, iz = inv * zs;
            u32x4 o; o.x = pk2(a[0] * iz - bflo(c.x) * zs, a[1] * iz - bfhi(c.x) * zs); o.y = pk2(a[2] * iz - bflo(c.y) * zs, a[3] * iz - bfhi(c.y) * zs);
            o.z = pk2(a[4] * iz - bflo(c.z) * zs, a[5] * iz - bfhi(c.z) * zs); o.w = pk2(a[6] * iz - bflo(c.w) * zs, a[7] * iz - bfhi(c.w) * zs);
            *(LAS u32x4*)(ldsQ + tl * 528 + c8 * 16) = o; }
        __syncthreads();
        f32x4 acc[8][2];
#pragma unroll
        for (int m = 0; m < 8; ++m) { acc[m][0] = (f32x4){0.f, 0.f, 0.f, 0.f}; acc[m][1] = acc[m][0]; }
#pragma unroll
        for (int ks = 0; ks < 8; ++ks) {
            const bf16x8 b[2] = {bw[ks][0], bw[ks][1]};
#pragma unroll
            for (int m = 0; m < 8; ++m) { const bf16x8 a = *(const LAS bf16x8*)(ldsQ + (16 * m + fr) * 528 + ks * 64 + fq * 16);
                acc[m][0] = __builtin_amdgcn_mfma_f32_16x16x32_bf16(b[0], a, acc[m][0], 0, 0, 0); acc[m][1] = __builtin_amdgcn_mfma_f32_16x16x32_bf16(b[1], a, acc[m][1], 0, 0, 0); }
        }
#pragma unroll
        for (int n = 0; n < 2; ++n) { const int d = 32 * w + 16 * n + 4 * fq; const f32x4 bg = bgq[n], sc = scq[n];
#pragma unroll
            for (int m = 0; m < 8; ++m) { const size_t row = (size_t)(row0 + 16 * m + fr);
                u32x2 o; o.x = pk2((acc[m][n][0] + bg[0]) * sc[0], (acc[m][n][1] + bg[1]) * sc[1]); o.y = pk2((acc[m][n][2] + bg[2]) * sc[2], (acc[m][n][3] + bg[3]) * sc[3]);
                *(u32x2*)(A2 + row * 1024 + 256 * g + d) = o; } }
        __syncthreads();
    }
}
constexpr int LDS_BYTES = 157696;
constexpr int LDS_CTL_OFF = 147456;
#ifndef SLQ
#define SLQ 1
#endif
#ifndef STOP_AFTER
#define STOP_AFTER 99
#endif
#ifndef REP_MASK
#define REP_MASK 0u
#endif
#define RUN(bit, ...) do { __VA_ARGS__; if ((REP_MASK >> (bit)) & 1u) { GRID_BAR(); __VA_ARGS__; } } while (0)

#define GEMM_ACT(Aptr, Bptr, nM_, nN_, K_, Optr, ldc_, gcols_) do { pg8::Sched S_; S_.init((Aptr), (Bptr), (nM_), (nN_), (K_), G, cid); pg8::EpiAct E_{(bf16_t*)(Optr), (ldc_), (gcols_)}; pg8::gemm_phase(F.lds, (K_), S_, E_, F.wave); } while (0)
#define GEMM_SWIGLU(Aptr, Bptr, nM_, nN_, K_, Optr, ldc_) do { pg8::Sched S_; S_.init((Aptr), (Bptr), (nM_), (nN_), (K_), G, cid); pg8::EpiSwiGLU E_{(bf16_t*)(Optr), (ldc_), 0}; pg8::gemm_phase(F.lds, (K_), S_, E_, F.wave); } while (0)

#define SLACK_CONV(s_) do { if (G == 256 && cid >= SL_FIRST[s_]) conv_slot(F, (s_), cid - SL_FIRST[s_]); } while (0)
#define FFN8_UP(l_, nM_) do { int k1_ = 1024; asm volatile("" : "+s"(k1_)); pg8::Sched S_; S_.init(ws + WS_H, ws + W_FGU + (size_t)(l_) * 11 * MiB, (nM_), 2 * DFF / 256, k1_, G, cid, 1); \
          pg8::EpiSwiGLU8 E_{ws + WS_BIG, DFF, 0, (float)(1 << FFN_SA2), 1.0f / (float)(1 << (FFN_SA1 + FFN_SB1)), 0}; pg8::gemm_phase<pg8::EpiSwiGLU8, 1>(F.lds, k1_, S_, E_, F.wave); } while (0)
#define FFN8_DOWN(l_, nM_) do { int k2_ = DFF; asm volatile("" : "+s"(k2_)); pg8::Sched S_; S_.init(ws + WS_BIG, ws + W_FD + (size_t)(l_) * 11 * MiB / 2, (nM_), 4, k2_, G, cid, 1); \
          pg8::EpiAct E_{(bf16_t*)(ws + WS_Y), 1024, 0}; pg8::gemm_phase<pg8::EpiAct, 1>(F.lds, k2_, S_, E_, F.wave); } while (0)
#define MOE_GEMM1(l_) MOE_GEMM1D(l_, 0)
#define MOE_GEMM1D(l_, dry_) do { int k1_ = 1024; int dr_ = (dry_); asm volatile("" : "+s"(dr_)); asm volatile("" : "+s"(k1_)); pg8::Sched S_; S_.init(ws + WS_BIG, ws + WS_WMOE + (size_t)(l_) * WM_LAYER, nt_total_, 2 * EFF / 256, k1_, G, cid, 1); S_.tile_exp = texp_; S_.b_estride = (size_t)2 * EFF * 1024; \
          pg8::EpiSwiGLU8 E_{ws + WS_BIG + 66 * MiB, EFF, 0, (float)(1 << MOE_SA2), 1.0f / (float)(1 << (MOE_SA1 + MOE_SB1)), dr_}; pg8::gemm_phase<pg8::EpiSwiGLU8, 1>(F.lds, k1_, S_, E_, F.wave); } while (0)
#define MOE_GEMM2(l_) do { int k2_ = EFF; asm volatile("" : "+s"(k2_)); pg8::Sched S_; S_.init(ws + WS_BIG + 66 * MiB, ws + WS_WMOE + (size_t)(l_) * WM_LAYER + WM_DOFF, nt_total_, 4, k2_, G, cid, 1); S_.tile_exp = texp_; S_.b_estride = (size_t)1024 * EFF; \
          pg8::EpiAct E_{(bf16_t*)(ws + WS_Y), 1024, 0};     pg8::gemm_phase<pg8::EpiAct, 1>(F.lds, k2_, S_, E_, F.wave); } while (0)
#ifdef NO_G1
#define MOE_G1(l_) do {} while (0)
#else
#define MOE_G1(l_) do { if ((REP_MASK >> 20) & 1u) { MOE_GEMM1D(l_, 1); GRID_BAR(); } RUN(12, MOE_GEMM1(l_)); } while (0)
#endif
#ifdef NO_G2
#define MOE_G2(l_) do {} while (0)
#else
#define MOE_G2(l_) RUN(13, MOE_GEMM2(l_))
#endif
#define MOE_BLOCK(l_) do { \
    RUN(11, moe_index_phase(F)); GRID_BAR(); \
    const int* cnts_ = (const int*)(ws + WS_COUNTS); const int nt_total_ = __builtin_amdgcn_readfirstlane(cnts_[5120]); \
    LAS int* texp_ = (LAS int*)(F.lds + 147712); { const int t_ = fresh_tid_w(F.wave); if (t_ < 272) texp_[t_] = cnts_[4096 + t_]; } __syncthreads(); \
    MOE_G1(l_); GRID_BAR(); \
    MOE_G2(l_); GRID_BAR(); } while (0)

__global__ void __launch_bounds__(NTHR, 2) hybrid_fwd(Params prm) {
    extern __shared__ __attribute__((aligned(16))) unsigned char lds_raw[];
    Frame F; F.lds = (LAS unsigned char*)lds_raw; F.tid = threadIdx.x; F.lane = F.tid & 63; F.wave = __builtin_amdgcn_readfirstlane(F.tid >> 6); asm volatile("" : "+s"(F.wave));
    F.G = gridDim.x; { const int bx = blockIdx.x; F.vcu = (F.G % 8 == 0) ? (bx % 8) * (F.G / 8) + bx / 8 : bx; }
    F.P = &prm; F.ws = prm.ws;
    volatile LAS unsigned* xbw = (volatile LAS unsigned*)(F.lds + LDS_CTL_OFF);
    if (F.tid < 4) xbw[F.tid] = 0u;
    __syncthreads();
    XcdBarrier bar = xcd_barrier_post((unsigned*)(F.ws + WS_CTL) + CW_BAR, xbw); bar.w = F.wave;
    unsigned char* ws = F.ws;
    const int G = F.G, cid = (int)blockIdx.x;
#ifdef DOUBLE_BAR
#define GRID_BAR() do { xcd_barrier(bar); xcd_barrier(bar); } while (0)
#else
#define GRID_BAR() xcd_barrier(bar)
#endif

    RUN(0, p0_prologue(F));
    GRID_BAR();
    norm1_phase(F);
    GRID_BAR();
#if STOP_AFTER >= 1
    RUN(1, GEMM_ACT(ws + WS_H, ws + W_GIN, MT / 256, 16, 1024, ws + WS_BIG, 4096, 4096));
    SLACK_CONV(0);
    GRID_BAR();
    RUN(2, vstats_phase(F));
    GRID_BAR();
    RUN(2, spatial_phase(F));
    GRID_BAR();
    RUN(3, GEMM_ACT(ws + WS_BIG + 260 * MiB, ws + W_GOUT, MT / 256, 4, 2048, ws + WS_Y, 1024, 0));
    SLACK_CONV(1);
    GRID_BAR();
    if ((REP_MASK >> 19) & 1u) { int dry_ = 1; asm volatile("" : "+s"(dry_)); post_phase<false, false, true, true, (FFN8_MASK & 1) != 0>(F, 0, 1, dry_ != 0); GRID_BAR(); }
    post_phase<false, false, true, true, (FFN8_MASK & 1) != 0>(F, 0, 1);
    GRID_BAR();
#endif
#if STOP_AFTER >= 2
#if FFN8_MASK & 1
    RUN(4, FFN8_UP(0, MT / 256));
    SLACK_CONV(2);
    GRID_BAR();
    RUN(5, FFN8_DOWN(0, MT / 256));
    SLACK_CONV(3);
#else
    RUN(4, GEMM_SWIGLU(ws + WS_H, ws + W_FGU, MT / 256, 2 * DFF / 256, 1024, ws + WS_BIG, DFF));
    SLACK_CONV(2);
    GRID_BAR();
    RUN(5, GEMM_ACT(ws + WS_BIG, ws + W_FD, MT / 256, 4, DFF, ws + WS_Y, 1024, 0));
    SLACK_CONV(3);
#endif
    GRID_BAR();
    if ((REP_MASK >> 19) & 1u) { int dry_ = 1; asm volatile("" : "+s"(dry_)); post_phase<false, false, true, true, LIN8 != 0>(F, 0, 2, dry_ != 0); GRID_BAR(); }
    post_phase<false, false, true, true, LIN8 != 0>(F, 0, 2);
    GRID_BAR();
#endif
#if STOP_AFTER >= 3
#if LIN8
    { int kl = 1024; asm volatile("" : "+s"(kl));
      RUN(6, { pg8::Sched S_; S_.init(ws + WS_H, ws + W_LIN, MT / 256, 8, kl, G, cid, 1); pg8::EpiActS E_{(bf16_t*)(ws + WS_BIG), 2048, 1024, 1.0f / (float)(1 << (FFN_SA1 + FFN_SB1))}; pg8::gemm_phase<pg8::EpiActS, 1>(F.lds, kl, S_, E_, F.wave); }); }
#else
    RUN(6, GEMM_ACT(ws + WS_H, ws + W_LIN, MT / 256, 8, 1024, ws + WS_BIG, 2048, 1024));
#endif
    SLACK_CONV(4);
    GRID_BAR();
    RUN(7, lru_gates_phase(F));
    GRID_BAR();
    RUN(8, lru_carry_phase(F));
    if (G == 256 && F.vcu >= 8) conv_slot(F, 5, F.vcu - 8);
    GRID_BAR();
    RUN(9, lru_scan_phase(F));
    GRID_BAR();
    RUN(10, GEMM_ACT(ws + WS_H, ws + W_LOUT, ML / 256, 4, 1024, ws + WS_Y, 1024, 0));
    GRID_BAR();
    if ((REP_MASK >> 19) & 1u) { int dry_ = 1; asm volatile("" : "+s"(dry_)); post_phase<false, true, true, false, true>(F, 1, 1, dry_ != 0); GRID_BAR(); }
    post_phase<false, true, true, false, true>(F, 1, 1);
    GRID_BAR();
#endif
#if STOP_AFTER >= 4
    MOE_BLOCK(0);
    if ((REP_MASK >> 19) & 1u) { int dry_ = 1; asm volatile("" : "+s"(dry_)); post_phase<true, false, true, false, HIN8 != 0>(F, 1, 2, dry_ != 0); GRID_BAR(); }
    post_phase<true, false, true, false, HIN8 != 0>(F, 1, 2);
    GRID_BAR();
#endif
#if STOP_AFTER >= 5
#if HIN8
    { int kh = 1024; asm volatile("" : "+s"(kh));
      RUN(14, { pg8::Sched S_; S_.init(ws + WS_H, ws + W_HIN, ML / 256, 12, kh, G, cid, 1); pg8::EpiAct E_{(bf16_t*)(ws + WS_BIG), 3072, 0}; pg8::gemm_phase<pg8::EpiAct, 1>(F.lds, kh, S_, E_, F.wave); }); }
#else
    RUN(14, GEMM_ACT(ws + WS_H, ws + W_HIN, ML / 256, 12, 1024, ws + WS_BIG, 3072, 0));
#endif
    { int kf = 256; asm volatile("" : "+s"(kf));
      RUN(14, { pg8::Sched S_; S_.init(ws + WS_HYW, ws + WS_HQ, 8, 128, kf, G, cid); pg8::EpiFilt E_{(bf16_t*)(ws + WS_Y)}; pg8::gemm_phase(F.lds, kf, S_, E_, F.wave); }); }
    GRID_BAR();
    RUN(15, hy_pack_phase(F));
    GRID_BAR();
    RUN(16, hy_fft_phase(F));
    GRID_BAR();
    RUN(17, hy_unpack_phase(F));
    GRID_BAR();
    RUN(10, GEMM_ACT(ws + WS_H, ws + W_HOUT, ML / 256, 4, 1024, ws + WS_Y, 1024, 0));
    GRID_BAR();
    if ((REP_MASK >> 19) & 1u) { int dry_ = 1; asm volatile("" : "+s"(dry_)); post_phase<false, false, true, false, (FFN8_MASK & 2) != 0>(F, 2, 1, dry_ != 0); GRID_BAR(); }
    post_phase<false, false, true, false, (FFN8_MASK & 2) != 0>(F, 2, 1);
    GRID_BAR();
#endif
#if STOP_AFTER >= 6
#if FFN8_MASK & 2
    RUN(4, FFN8_UP(1, ML / 256));
    GRID_BAR();
    RUN(5, FFN8_DOWN(1, ML / 256));
#else
    RUN(4, GEMM_SWIGLU(ws + WS_H, ws + W_FGU + 11 * MiB, ML / 256, 2 * DFF / 256, 1024, ws + WS_BIG, DFF));
    GRID_BAR();
    RUN(5, GEMM_ACT(ws + WS_BIG, ws + W_FD + 11 * MiB / 2, ML / 256, 4, DFF, ws + WS_Y, 1024, 0));
#endif
    GRID_BAR();
    if ((REP_MASK >> 19) & 1u) { int dry_ = 1; asm volatile("" : "+s"(dry_)); post_phase<false, false, true, false, PIN8 != 0>(F, 2, 2, dry_ != 0); GRID_BAR(); }
    post_phase<false, false, true, false, PIN8 != 0>(F, 2, 2);
    GRID_BAR();
#endif
#if STOP_AFTER >= 7
#if PIN8
    { int kq = 1024; asm volatile("" : "+s"(kq));
      RUN(10, { pg8::Sched S_; S_.init(ws + WS_H, ws + W_PIN, ML / 256, 4, kq, G, cid, 1); pg8::EpiAct E_{(bf16_t*)(ws + WS_BIG), 1024, 0}; pg8::gemm_phase<pg8::EpiAct, 1>(F.lds, kq, S_, E_, F.wave); }); }
#else
    RUN(10, GEMM_ACT(ws + WS_H, ws + W_PIN, ML / 256, 4, 1024, ws + WS_BIG, 1024, 0));
#endif
    GRID_BAR();
    RUN(18, pool_phase(F));
    GRID_BAR();
    RUN(10, GEMM_ACT(ws + WS_BIG + 64 * MiB, ws + W_POUT, ML / 256, 4, 1024, ws + WS_Y, 1024, 0));
    GRID_BAR();
    if ((REP_MASK >> 19) & 1u) { int dry_ = 1; asm volatile("" : "+s"(dry_)); post_phase<false, true, true, false, true>(F, 3, 1, dry_ != 0); GRID_BAR(); }
    post_phase<false, true, true, false, true>(F, 3, 1);
    GRID_BAR();
#endif
#if STOP_AFTER >= 8
    MOE_BLOCK(1);
    if ((REP_MASK >> 19) & 1u) { int dry_ = 1; asm volatile("" : "+s"(dry_)); post_phase<true, false, false, false>(F, 3, 2, dry_ != 0); GRID_BAR(); }
    post_phase<true, false, false, false>(F, 3, 2);
#endif
}

extern "C" void kernel_launch(void* const* d_in, const int* in_sizes, int n_in, void* d_out, int out_size, void* d_ws, size_t ws_size, hipStream_t stream) {
    static int grid = 0;
    if (grid == 0) {
        if (n_in != 46 || out_size != ML * D || ws_size < WS_END) { fprintf(stderr, "kernel_launch: unexpected sizes n_in %d out %d ws %zu (need %zu)\n", n_in, out_size, ws_size, (size_t)WS_END); grid = -1; return; }
        int dev = 0, cus = 0, per_cu = 0;
        if (hipGetDevice(&dev) != hipSuccess || hipDeviceGetAttribute(&cus, hipDeviceAttributeMultiprocessorCount, dev) != hipSuccess) { grid = -1; return; }
        if (hipFuncSetAttribute((const void*)hybrid_fwd, hipFuncAttributeMaxDynamicSharedMemorySize, LDS_BYTES) != hipSuccess) { fprintf(stderr, "kernel_launch: hipFuncSetAttribute failed\n"); grid = -1; return; }
        if (hipOccupancyMaxActiveBlocksPerMultiprocessor(&per_cu, (const void*)hybrid_fwd, NTHR, LDS_BYTES) != hipSuccess || per_cu < 1) { fprintf(stderr, "kernel_launch: occupancy query says %d\n", per_cu); }
        (void)hipGetLastError();
        grid = cus;
        if (grid > 256) grid = 256;
    }
    if (grid < 0) return;
    if (hipMemsetAsync((char*)d_ws + WS_CTL, 0, CTL_ZERO_BYTES, stream) != hipSuccess) return;
    Params p{};
    for (int i = 0; i < 46; ++i) p.in[i] = (const float*)d_in[i];
    p.out = (float*)d_out; p.ws = (unsigned char*)d_ws;
    hipLaunchKernelGGL(hybrid_fwd, dim3(grid), dim3(NTHR), LDS_BYTES, stream, p);
}
```

```cpp
#define STOP_AFTER 99
#define FFN8_MASK 3
#include <hip/hip_runtime.h>
#include <math.h>
#include <stdio.h>

#define LAS __attribute__((address_space(3)))
typedef unsigned short bf16_t;
typedef short bf16x8 __attribute__((ext_vector_type(8)));
typedef float f32x4 __attribute__((ext_vector_type(4)));
typedef float f32x2 __attribute__((ext_vector_type(2)));
typedef float f32x16 __attribute__((ext_vector_type(16)));
typedef unsigned u32x4 __attribute__((ext_vector_type(4)));
typedef unsigned u32x2 __attribute__((ext_vector_type(2)));

constexpr int D = 1024, SEQ = 16384, ML = 32768, CTXL = 256, MC = 512, MT = ML + MC;
constexpr int GW = 2048;
constexpr int DFF = 2816, EFF = 3584, NEXP = 8;
constexpr float EPS = 1e-6f;
constexpr int NWAVES = 8, NTHR = 512;
constexpr int MOE_MAXT = 264;
constexpr int MOE_CHUNK = 132;

constexpr size_t MiB = (size_t)1 << 20;
constexpr size_t WS_CTL = 0, CTL_ZERO_BYTES = 32 * 1024;
constexpr size_t WS_MOD = 1 * MiB;
constexpr size_t WS_PE = 2 * MiB;
constexpr size_t WS_XC = 3 * MiB;
constexpr size_t WS_ROUTE = 5 * MiB;
constexpr size_t WS_ROWSTAT = 6 * MiB;
constexpr size_t WS_COUNTS = 7 * MiB;
constexpr size_t WS_AGG = 8 * MiB;
constexpr size_t WS_CARRY = 17 * MiB;
constexpr size_t WS_WS16 = 21 * MiB;
constexpr size_t WS_LRUW = 21 * MiB + 512 * 1024;
constexpr size_t WS_POOLW = 22 * MiB + 512 * 1024;
constexpr size_t WS_HYW = 23 * MiB;
constexpr size_t WS_HQ = 24 * MiB;
constexpr size_t WS_W = 40 * MiB;
constexpr size_t W_GIN = WS_W, W_GOUT = W_GIN + 8 * MiB, W_LIN = W_GOUT + 4 * MiB, W_LOUT = W_LIN + 4 * MiB, W_HIN = W_LOUT + 2 * MiB, W_HOUT = W_HIN + 6 * MiB,
                 W_PIN = W_HOUT + 2 * MiB, W_POUT = W_PIN + 2 * MiB, W_FGU = W_POUT + 2 * MiB  , W_FD = W_FGU + 22 * MiB  , W_END = W_FD + 11 * MiB;
static_assert(W_END <= 104 * MiB, "weights");
constexpr size_t WS_WMOE = 104 * MiB;
constexpr size_t WM_GU = WS_WMOE, WM_D = WS_WMOE + 112 * MiB;
constexpr size_t WS_H = 272 * MiB;
constexpr size_t WS_Y = 337 * MiB;
constexpr size_t WS_BIG = 469 * MiB;
constexpr size_t WS_XB = 859 * MiB;
constexpr size_t WS_END = 923 * MiB;
constexpr int CW_BAR = 4096;

typedef __bf16 bf16x2v __attribute__((ext_vector_type(2)));
__device__ __forceinline__ unsigned pk2(float lo, float hi) { const f32x2 f = {lo, hi}; const bf16x2v b = __builtin_convertvector(f, bf16x2v); return __builtin_bit_cast(unsigned, b); }
__device__ __forceinline__ unsigned f2bf(float f) { return pk2(f, 0.0f) & 0xffffu; }
__device__ __forceinline__ float bflo(unsigned w) { return __builtin_bit_cast(float, w << 16); }
__device__ __forceinline__ float bfhi(unsigned w) { return __builtin_bit_cast(float, w & 0xffff0000u); }
__device__ __forceinline__ float bf1(bf16_t h) { return __builtin_bit_cast(float, ((unsigned)h) << 16); }
__device__ __forceinline__ float wave_sum(float v) {
#define WS_DPP(ctrl_, rmask_) v += __builtin_bit_cast(float, __builtin_amdgcn_update_dpp(0, __builtin_bit_cast(int, v), (ctrl_), (rmask_), 0xf, false))
    WS_DPP(0xB1, 0xf);
    WS_DPP(0x4E, 0xf);
    WS_DPP(0x141, 0xf);
    WS_DPP(0x140, 0xf);
    WS_DPP(0x142, 0xa);
    WS_DPP(0x143, 0xc);
#undef WS_DPP
    return __builtin_bit_cast(float, __builtin_amdgcn_readlane(__builtin_bit_cast(int, v), 63));
}
__device__ __forceinline__ float fexp_(float x) { return __builtin_amdgcn_exp2f(x * 1.4426950408889634f); }
__device__ __forceinline__ float sigmoidf_(float x) { return __builtin_amdgcn_rcpf(1.0f + fexp_(-x)); }
__device__ __forceinline__ float siluf_(float x) { return x * __builtin_amdgcn_rcpf(1.0f + fexp_(-x)); }
__device__ __forceinline__ float gelu_tanh(float x) { const float u = -2.302208198f * (x + 0.044715f * x * x * x); return x * __builtin_amdgcn_rcpf(1.0f + __builtin_amdgcn_exp2f(u)); }
typedef int i32x4 __attribute__((ext_vector_type(4)));
typedef int i32x8 __attribute__((ext_vector_type(8)));
__device__ __forceinline__ float clamp448(float x) { return __builtin_fminf(__builtin_fmaxf(x, -448.0f), 448.0f); }
__device__ __forceinline__ unsigned pk4_fp8(float a, float b, float c, float d) {
    int r = 0; r = __builtin_amdgcn_cvt_pk_fp8_f32(clamp448(a), clamp448(b), r, false); r = __builtin_amdgcn_cvt_pk_fp8_f32(clamp448(c), clamp448(d), r, true); return (unsigned)r; }
#define LDS_WAIT() asm volatile("s_waitcnt lgkmcnt(0)" ::: "memory")
#define VM_WAIT() asm volatile("s_waitcnt vmcnt(0)" ::: "memory")
#define XB_TMO      128
#define XB_XCNT(j)  (256  + 64 * (j))
#define XB_XSUB(j)  (1280 + 64 * (j))
#define XB_XGEN(j)  (2304 + 64 * (j))
#define XB_TOP      3328
#define XB_TOPGEN   3392
#define XCD_BAR_WORDS 3456
#define XB_SPIN_CAP (1u << 18)
__device__ __forceinline__ unsigned xb_ld(unsigned* p)              { return __hip_atomic_load(p, __ATOMIC_RELAXED, __HIP_MEMORY_SCOPE_AGENT); }
__device__ __forceinline__ unsigned xb_add(unsigned* p, unsigned v) { return __hip_atomic_fetch_add(p, v, __ATOMIC_RELAXED, __HIP_MEMORY_SCOPE_AGENT); }
__device__ __forceinline__ unsigned xb_xcc_id() { return (unsigned)__builtin_amdgcn_s_getreg((3 << 11) | 20) & 0xFu; }
#define XB_SPIN(cond, bar) do { unsigned _sp = 0; while (cond) { __builtin_amdgcn_s_sleep(1); \
    if ((++_sp & 255u) == 0u) { if (xb_ld(&(bar)[XB_TMO])) break; if (_sp > XB_SPIN_CAP) { atomicAdd(&(bar)[XB_TMO], 1u); break; } } } } while (0)

__device__ __forceinline__ int lane_now() { int l; asm volatile("v_mbcnt_lo_u32_b32 %0, -1, 0\n\tv_mbcnt_hi_u32_b32 %0, -1, %0" : "=v"(l)); return l; }
struct XcdBarrier {
    unsigned* bar; unsigned x;
    int w;
    volatile LAS unsigned* st;
};

__device__ __forceinline__ XcdBarrier xcd_barrier_post(unsigned* bar, volatile LAS unsigned* st) {
    XcdBarrier b; b.bar = bar; b.x = xb_xcc_id(); b.st = st; b.w = 0;
    if (threadIdx.x == 0) (void)xb_add(&bar[XB_XCNT(b.x)], 1u);
    return b;
}
__device__ __forceinline__ void xcd_barrier_complete(unsigned* bar, unsigned x, unsigned& nloc, unsigned& nx) {
    const unsigned G = gridDim.x * gridDim.y * gridDim.z;
    unsigned sum, cnt, mine, sp = 0u;
    for (;;) {
        sum = 0u; cnt = 0u; mine = 0u;
#pragma unroll
        for (unsigned j = 0; j < 16; ++j) { const unsigned c = xb_ld(&bar[XB_XCNT(j)]); sum += c; cnt += (c > 0u) ? 1u : 0u; mine = (j == x) ? c : mine; }
        if (sum == G) break;
        __builtin_amdgcn_s_sleep(1);
        if ((++sp & 255u) == 0u) { if (xb_ld(&bar[XB_TMO])) break; if (sp > XB_SPIN_CAP) { atomicAdd(&bar[XB_TMO], 1u); break; } }
    }
    nloc = mine > 0u ? mine : 1u; nx = cnt > 0u ? cnt : 1u;
}

__device__ __forceinline__ void xcd_barrier(const XcdBarrier& b) {
    asm volatile("s_waitcnt vmcnt(0)" ::: "memory");
    __syncthreads();
    if (b.w == 0 && lane_now() == 0) {
        unsigned* bar = b.bar;
        __builtin_amdgcn_s_waitcnt(0);
        unsigned nloc = b.st[0], nx = b.st[1];
        if (nloc == 0u) { xcd_barrier_complete(bar, b.x, nloc, nx); b.st[0] = nloc; b.st[1] = nx; }
        const unsigned old = xb_add(&bar[XB_XSUB(b.x)], 1u);
        const unsigned gen = old / nloc;
        if (old + 1u == (gen + 1u) * nloc) {
            __builtin_amdgcn_fence(__ATOMIC_RELEASE, "agent");
            asm volatile("s_waitcnt vmcnt(0)" ::: "memory");
            const unsigned og = xb_add(&bar[XB_TOP], 1u);
            const unsigned tg = og / nx;
            if (og + 1u == (tg + 1u) * nx) xb_add(&bar[XB_TOPGEN], 1u);
            else XB_SPIN(xb_ld(&bar[XB_TOPGEN]) == tg, bar);
            __builtin_amdgcn_fence(__ATOMIC_ACQUIRE, "agent");
            xb_add(&bar[XB_XGEN(b.x)], 1u);
            asm volatile("s_waitcnt vmcnt(0)" ::: "memory");
        } else {
            XB_SPIN(xb_ld(&bar[XB_XGEN(b.x)]) == gen, bar);
            __builtin_amdgcn_fence(__ATOMIC_ACQUIRE, "agent");
            asm volatile("s_waitcnt vmcnt(0)" ::: "memory");
        }
    }
    __syncthreads();
}
namespace pg8 {
constexpr int BM = 256, BK = 64, HALF = 128, HTB = HALF * BK * 2, STAGE_BYTES = 8 * HTB, NXCD = 8, WGM = 8;
__host__ __device__ __forceinline__ int lds_byte(int r, int c) { const int st = (r >> 4) * 2 + (c >> 5), rr = r & 15, cc = c & 31, ob = rr * 64 + cc * 2; return st * 1024 + (ob ^ (((ob >> 9) & 1) << 5)); }
__host__ __device__ __forceinline__ void stage_rc(int b, int& R, int& C) { const int st = b / 1024, sb = b % 1024, swz = sb ^ (((sb >> 9) & 1) << 5); R = (st >> 1) * 16 + swz / 64; C = (st & 1) * 32 + (swz % 64) / 2; }
__host__ __device__ __forceinline__ int perm32(int rho) { const int n = rho >> 4, i = rho & 15; return 8 * (i >> 2) + 4 * n + (i & 3); }

struct Unit { int pm, pn; };

struct Sched {
    int nM, nN, nwg, G, c, pm0; const char* A; const char* Bt; size_t a_tstep, b_tstep, b_estride; const LAS int* tile_exp;
    __device__ __forceinline__ void init(const void* A_, const void* Bt_, int nM_, int nN_, int K, int G_, int c_, int eb = 2) {
        nM = nM_; nN = nN_; nwg = nM * nN; G = G_; c = c_; pm0 = 0; A = (const char*)A_; Bt = (const char*)Bt_; a_tstep = (size_t)BM * K * eb; b_tstep = a_tstep; b_estride = 0; tile_exp = nullptr; }
    __device__ __forceinline__ bool next(int i, Unit& u) const {
        const long L = (long)i * G + c; if (L >= nwg) return false;
        int wgid = (int)L; { const int q = nwg / NXCD, r = nwg % NXCD, xcd = wgid % NXCD, off = wgid / NXCD; wgid = (xcd < r ? xcd * (q + 1) : r * (q + 1) + (xcd - r) * q) + off; }
        const int nig = WGM * nN, gid = wgid / nig, fm = gid * WGM, gsz = (nM - fm) < WGM ? (nM - fm) : WGM;
        u.pm = pm0 + fm + ((wgid % nig) % gsz); u.pn = (wgid % nig) / gsz; return true;
    }
    __device__ __forceinline__ const char* aptr(const Unit& u) const { return A + (size_t)(u.pm - pm0) * a_tstep; }
    __device__ __forceinline__ const char* bptr(const Unit& u) const { return Bt + (tile_exp ? (size_t)tile_exp[u.pm] * b_estride : (size_t)0) + (size_t)u.pn * b_tstep; }
};

__device__ __forceinline__ unsigned cvt_pk_bf16(float lo, float hi) { unsigned r; asm volatile("v_cvt_pk_bf16_f32 %0, %1, %2" : "=v"(r) : "v"(lo), "v"(hi)); return r; }

struct EpiAct {
    static constexpr bool PERM = true;
    bf16_t* O; int ldc; int gelu_cols;
    __device__ __forceinline__ void operator()(const f32x4 (&acc)[2][2][4][2], const Unit& u, int wr, int wc, int fr, int fq) const {
        const int row0 = u.pm * BM + wr * 64 + fr; const int col0 = u.pn * BM + wc * 32 + 8 * fq; const bool act = (u.pn * BM) < gelu_cols;
#pragma unroll
        for (int ai = 0; ai < 2; ++ai)
#pragma unroll
            for (int m = 0; m < 4; ++m) { bf16_t* rowp = O + (size_t)(row0 + ai * HALF + m * 16) * ldc + col0;
#pragma unroll
                for (int bj = 0; bj < 2; ++bj) { f32x4 v0 = acc[ai][bj][m][0], v1 = acc[ai][bj][m][1];
                    if (act) {
#pragma unroll
                        for (int j = 0; j < 4; ++j) { v0[j] = gelu_tanh(v0[j]); v1[j] = gelu_tanh(v1[j]); } }
                    u32x4 w; w.x = cvt_pk_bf16(v0[0], v0[1]); w.y = cvt_pk_bf16(v0[2], v0[3]); w.z = cvt_pk_bf16(v1[0], v1[1]); w.w = cvt_pk_bf16(v1[2], v1[3]);
                    *(u32x4*)(rowp + bj * HALF) = w; } }
    }
};
struct EpiActS {
    static constexpr bool PERM = true;
    bf16_t* O; int ldc; int gelu_cols; float gscale;
    __device__ __forceinline__ void operator()(const f32x4 (&acc)[2][2][4][2], const Unit& u, int wr, int wc, int fr, int fq) const {
        const int row0 = u.pm * BM + wr * 64 + fr; const int col0 = u.pn * BM + wc * 32 + 8 * fq; const bool act = (u.pn * BM) < gelu_cols;
#pragma unroll
        for (int ai = 0; ai < 2; ++ai)
#pragma unroll
            for (int m = 0; m < 4; ++m) { bf16_t* rowp = O + (size_t)(row0 + ai * HALF + m * 16) * ldc + col0;
#pragma unroll
                for (int bj = 0; bj < 2; ++bj) { f32x4 v0 = acc[ai][bj][m][0], v1 = acc[ai][bj][m][1];
                    if (act) {
#pragma unroll
                        for (int j = 0; j < 4; ++j) { v0[j] = gelu_tanh(v0[j] * gscale); v1[j] = gelu_tanh(v1[j] * gscale); } }
                    u32x4 w; w.x = cvt_pk_bf16(v0[0], v0[1]); w.y = cvt_pk_bf16(v0[2], v0[3]); w.z = cvt_pk_bf16(v1[0], v1[1]); w.w = cvt_pk_bf16(v1[2], v1[3]);
                    *(u32x4*)(rowp + bj * HALF) = w; } }
    }
};
struct EpiGeluStats {
    static constexpr bool PERM = true;
    bf16_t* O; int ldc; f32x2* part;
    __device__ __forceinline__ void operator()(const f32x4 (&acc)[2][2][4][2], const Unit& u, int wr, int wc, int fr, int fq) const {
        const int row0 = u.pm * BM + wr * 64 + fr; const int col0 = u.pn * BM + wc * 32 + 8 * fq; const bool isv = u.pn >= 8;
#pragma unroll
        for (int ai = 0; ai < 2; ++ai)
#pragma unroll
            for (int m = 0; m < 4; ++m) { const int row = row0 + ai * HALF + m * 16; bf16_t* rowp = O + (size_t)row * ldc + col0; float s = 0.f, q = 0.f;
#pragma unroll
                for (int bj = 0; bj < 2; ++bj) { f32x4 v0 = acc[ai][bj][m][0], v1 = acc[ai][bj][m][1];
#pragma unroll
                    for (int j = 0; j < 4; ++j) { v0[j] = gelu_tanh(v0[j]); v1[j] = gelu_tanh(v1[j]); s += v0[j] + v1[j]; q += v0[j] * v0[j] + v1[j] * v1[j]; }
                    u32x4 w; w.x = cvt_pk_bf16(v0[0], v0[1]); w.y = cvt_pk_bf16(v0[2], v0[3]); w.z = cvt_pk_bf16(v1[0], v1[1]); w.w = cvt_pk_bf16(v1[2], v1[3]);
                    *(u32x4*)(rowp + bj * HALF) = w; }
                if (isv) { s += __shfl_xor(s, 16); q += __shfl_xor(q, 16); s += __shfl_xor(s, 32); q += __shfl_xor(q, 32);
                    if (fq == 0) part[(size_t)row * 32 + (u.pn - 8) * 4 + wc] = (f32x2){s, q}; } }
    }
};
struct EpiSwiGLU {
    static constexpr bool PERM = true;
    bf16_t* O; int ldc; int pm_sub;
    __device__ __forceinline__ void operator()(const f32x4 (&acc)[2][2][4][2], const Unit& u, int wr, int wc, int fr, int fq) const {
        const int row0 = (u.pm - pm_sub) * BM + wr * 64 + fr; const int col0 = u.pn * HALF + wc * 32 + 8 * fq;
#pragma unroll
        for (int ai = 0; ai < 2; ++ai)
#pragma unroll
            for (int m = 0; m < 4; ++m) { bf16_t* rowp = O + (size_t)(row0 + ai * HALF + m * 16) * ldc + col0;
                f32x4 g0 = acc[ai][0][m][0], g1 = acc[ai][0][m][1]; const f32x4 u0 = acc[ai][1][m][0], u1 = acc[ai][1][m][1];
#pragma unroll
                for (int j = 0; j < 4; ++j) { g0[j] = siluf_(g0[j]) * u0[j]; g1[j] = siluf_(g1[j]) * u1[j]; }
                u32x4 w; w.x = cvt_pk_bf16(g0[0], g0[1]); w.y = cvt_pk_bf16(g0[2], g0[3]); w.z = cvt_pk_bf16(g1[0], g1[1]); w.w = cvt_pk_bf16(g1[2], g1[3]);
                *(u32x4*)rowp = w; }
    }
};
struct EpiSwiGLU8 {
    static constexpr bool PERM = true;
    unsigned char* O; int ldc; int pm_sub; float oscale, iscale; int dry;
    __device__ __forceinline__ void operator()(const f32x4 (&acc)[2][2][4][2], const Unit& u, int wr, int wc, int fr, int fq) const {
        if (dry) return;
        const int row0 = (u.pm - pm_sub) * BM + wr * 64 + fr; const int col0 = u.pn * HALF + wc * 32 + 8 * fq;
        const float kexp = -1.4426950408889634f * iscale, cinv = 1.0f / (iscale * iscale * oscale);
#pragma unroll
        for (int ai = 0; ai < 2; ++ai)
#pragma unroll
            for (int m = 0; m < 4; ++m) { unsigned char* rowp = O + (size_t)(row0 + ai * HALF + m * 16) * ldc + col0;
                f32x4 g0 = acc[ai][0][m][0], g1 = acc[ai][0][m][1]; const f32x4 u0 = acc[ai][1][m][0], u1 = acc[ai][1][m][1];
#pragma unroll
                for (int j = 0; j < 4; ++j) { g0[j] = (g0[j] * u0[j]) * __builtin_amdgcn_rcpf(__builtin_fmaf(__builtin_amdgcn_exp2f(g0[j] * kexp), cinv, cinv)); g1[j] = (g1[j] * u1[j]) * __builtin_amdgcn_rcpf(__builtin_fmaf(__builtin_amdgcn_exp2f(g1[j] * kexp), cinv, cinv)); }
                u32x2 w; w.x = pk4_fp8(g0[0], g0[1], g0[2], g0[3]); w.y = pk4_fp8(g1[0], g1[1], g1[2], g1[3]);
                *(u32x2*)rowp = w; }
    }
};
struct EpiFilt {
    static constexpr bool PERM = true;
    bf16_t* O;
    __device__ __forceinline__ void operator()(const f32x4 (&acc)[2][2][4][2], const Unit& u, int wr, int wc, int fr, int fq) const {
        const int row0 = u.pm * BM + wr * 64 + fr; const int col0 = u.pn * BM + wc * 32 + 8 * fq;
#pragma unroll
        for (int ai = 0; ai < 2; ++ai)
#pragma unroll
            for (int m = 0; m < 4; ++m) { const int row = row0 + ai * HALF + m * 16; const int ch = row & 1023;
                const float dl = (3.0701134573253945f + 12.280453829301578f * ((float)ch * (1.0f / 1023.0f))) * (1.4426950408889634f / 16383.0f);
                bf16_t* rowp = O + (size_t)row * 32768 + col0;
#pragma unroll
                for (int bj = 0; bj < 2; ++bj) { const int q = col0 + bj * HALF; const int n0 = q >> 10, n1 = (q >> 5) & 31, n2 = q & 31;
                    const int nn = n0 + 32 * n1 + 1024 * n2; const bool fwd = nn < 16384; const int t0 = fwd ? nn : 32768 - nn;
                    float wv = exp2f(-(float)t0 * dl); const float rr = exp2f(fwd ? -1024.0f * dl : 1024.0f * dl);
                    const f32x4 v0 = acc[ai][bj][m][0], v1 = acc[ai][bj][m][1]; float o[8];
#pragma unroll
                    for (int j = 0; j < 8; ++j) { o[j] = (j < 4 ? v0[j & 3] : v1[j & 3]) * wv; wv *= rr; }
                    u32x4 w; w.x = cvt_pk_bf16(o[0], o[1]); w.y = cvt_pk_bf16(o[2], o[3]); w.z = cvt_pk_bf16(o[4], o[5]); w.w = cvt_pk_bf16(o[6], o[7]);
                    *(u32x4*)(rowp + bj * HALF) = w; } }
    }
};

template <int EB> struct Frag { typedef bf16x8 A[4][2]; typedef bf16x8 B[2][2]; };
template <> struct Frag<1> { typedef i32x8 A[4]; typedef i32x8 B[2]; };
template <class Epi, int EB = 2>
__device__ __forceinline__ void gemm_phase(LAS unsigned char* lds, const int K, const Sched& S, const Epi& E, const int wave) {
    const int tid_ = wave * 64 + lane_now();
    const int tid = tid_, wid = wave, lane = tid & 63, wr = wid >> 2, wc = wid & 3, fr = lane & 15, fq = lane >> 4;
    const int KB = K * EB;
    const int nt = KB / 128;
    unsigned voffA[2], voffB[2];
#pragma unroll
    for (int i = 0; i < 2; ++i) { int R, C; stage_rc(tid * 16 + i * 8192, R, C); const int Rb = Epi::PERM ? ((R & ~31) + perm32(R & 31)) : R;
        voffA[i] = (unsigned)(R * KB + C * 2); voffB[i] = (unsigned)(Rb * KB + C * 2); }
    const size_t kstep = (size_t)128;
    const size_t hstep = (size_t)HALF * KB;
    const unsigned ldsw = (unsigned)wid * 1024u;
    const int aoff = lds_byte(wr * 64 + fr, fq * 8), boff = lds_byte(wc * 32 + fr, fq * 8);
#define PG8_SA(b, h) (((b) * 2 + (h)) * HTB)
#define PG8_SB(b, h) ((4 + (b) * 2 + (h)) * HTB)
#define PG8_STAGE(bufoff, gbase, voff) do { _Pragma("unroll") for (int _i = 0; _i < 2; ++_i) \
        __builtin_amdgcn_global_load_lds((const unsigned*)((const char*)(gbase) + (voff)[_i]), (LAS unsigned*)(lds + (bufoff) + ldsw + _i * 8192), 16, 0, 0); } while (0)
#define PG8_LDA(dst, b, h) do { if constexpr (EB == 2) { _Pragma("unroll") for (int m = 0; m < 4; ++m) _Pragma("unroll") for (int k = 0; k < 2; ++k) dst[m][k] = *(const LAS bf16x8*)(lds + PG8_SA(b, h) + aoff + m * 2048 + k * 1024); } \
        else { _Pragma("unroll") for (int m = 0; m < 4; ++m) dst[m] = PG8_CAT8(*(const LAS i32x4*)(lds + PG8_SA(b, h) + aoff + m * 2048), *(const LAS i32x4*)(lds + PG8_SA(b, h) + aoff + m * 2048 + 1024)); } } while (0)
#define PG8_LDB(dst, b, h) do { if constexpr (EB == 2) { _Pragma("unroll") for (int n = 0; n < 2; ++n) _Pragma("unroll") for (int k = 0; k < 2; ++k) dst[n][k] = *(const LAS bf16x8*)(lds + PG8_SB(b, h) + boff + n * 2048 + k * 1024); } \
        else { _Pragma("unroll") for (int n = 0; n < 2; ++n) dst[n] = PG8_CAT8(*(const LAS i32x4*)(lds + PG8_SB(b, h) + boff + n * 2048), *(const LAS i32x4*)(lds + PG8_SB(b, h) + boff + n * 2048 + 1024)); } } while (0)
#define PG8_CAT8(x, y) __builtin_shufflevector(__builtin_bit_cast(i32x4, (x)), __builtin_bit_cast(i32x4, (y)), 0, 1, 2, 3, 4, 5, 6, 7)
#define PG8_MMA(ai, bj, At, Bt) do { __builtin_amdgcn_s_setprio(1); \
        if constexpr (EB == 2) { _Pragma("unroll") for (int m = 0; m < 4; ++m) _Pragma("unroll") for (int n = 0; n < 2; ++n) _Pragma("unroll") for (int k = 0; k < 2; ++k) \
            acc[ai][bj][m][n] = __builtin_amdgcn_mfma_f32_16x16x32_bf16(Bt[n][k], At[m][k], acc[ai][bj][m][n], 0, 0, 0); } \
        else { _Pragma("unroll") for (int m = 0; m < 4; ++m) _Pragma("unroll") for (int n = 0; n < 2; ++n) \
            asm volatile("v_mfma_f32_16x16x128_f8f6f4 %0, %1, %2, %0" : "+v"(acc[ai][bj][m][n]) : "v"(Bt[n]), "v"(At[m])); } \
        __builtin_amdgcn_s_setprio(0); } while (0)
#define PG8_WAIT_V(n) asm volatile("s_waitcnt vmcnt(" #n ")" ::: "memory")
#define PG8_WAIT_L(n) asm volatile("s_waitcnt lgkmcnt(" #n ")" ::: "memory")
#define PG8_BAR __builtin_amdgcn_s_barrier()
#define PG8_SCHED __builtin_amdgcn_sched_barrier(0)
#define PG8_SCHED8 do { if constexpr (EB == 1) __builtin_amdgcn_sched_barrier(0); } while (0)
    Unit cur, nxt; int ui = 0;
    if (!S.next(0, cur)) return;
    f32x4 acc[2][2][4][2];
#pragma unroll
    for (int a = 0; a < 2; ++a)
#pragma unroll
        for (int b = 0; b < 2; ++b)
#pragma unroll
            for (int m = 0; m < 4; ++m)
#pragma unroll
                for (int n = 0; n < 2; ++n) acc[a][b][m][n] = (f32x4){0.f, 0.f, 0.f, 0.f};
    typename Frag<EB>::A At; typename Frag<EB>::B B0, B1;
    const char* cA = S.aptr(cur); const char* cB = S.bptr(cur);
    PG8_STAGE(PG8_SB(0, 0), cB, voffB); PG8_STAGE(PG8_SA(0, 0), cA, voffA); PG8_STAGE(PG8_SB(0, 1), cB + hstep, voffB); PG8_STAGE(PG8_SA(0, 1), cA + hstep, voffA);
    if (wr == 1) PG8_BAR;
    PG8_WAIT_V(4); PG8_BAR;
    PG8_STAGE(PG8_SB(1, 0), cB + kstep, voffB); PG8_STAGE(PG8_SA(1, 0), cA + kstep, voffA); PG8_STAGE(PG8_SB(1, 1), cB + hstep + kstep, voffB);
    PG8_WAIT_V(6); PG8_BAR;
    for (;;) {
        const bool has_next = S.next(ui + 1, nxt);
        const char* nA = has_next ? S.aptr(nxt) : cA; const char* nB = has_next ? S.bptr(nxt) : cB;
        for (int t = 0; t < nt; t += 2) {
            const bool last = (t == nt - 2);
            const char* a1 = cA + (size_t)(t + 1) * kstep;
            const char* a2 = last ? nA : cA + (size_t)(t + 2) * kstep; const char* b2 = last ? nB : cB + (size_t)(t + 2) * kstep;
            const char* a3 = a2 + kstep; const char* b3 = b2 + kstep;
            PG8_LDB(B0, 0, 0); PG8_SCHED; PG8_LDA(At, 0, 0); PG8_STAGE(PG8_SA(1, 1), a1 + hstep, voffA);
            PG8_WAIT_L(8); PG8_BAR; PG8_WAIT_L(0); PG8_MMA(0, 0, At, B0); PG8_BAR; PG8_SCHED;
            PG8_LDB(B1, 0, 1); PG8_STAGE(PG8_SB(0, 0), b2, voffB);
            PG8_BAR; PG8_WAIT_L(0); PG8_MMA(0, 1, At, B1); PG8_BAR; PG8_SCHED8;
            PG8_LDA(At, 0, 1); PG8_STAGE(PG8_SA(0, 0), a2, voffA);
            PG8_BAR; PG8_WAIT_L(0); PG8_MMA(1, 0, At, B0); PG8_BAR; PG8_SCHED;
            PG8_STAGE(PG8_SB(0, 1), b2 + hstep, voffB);
            PG8_WAIT_V(6); PG8_BAR; PG8_MMA(1, 1, At, B1); PG8_BAR; PG8_SCHED8;
            PG8_LDB(B0, 1, 0); PG8_SCHED; PG8_LDA(At, 1, 0); PG8_STAGE(PG8_SA(0, 1), a2 + hstep, voffA);
            PG8_WAIT_L(8); PG8_BAR; PG8_WAIT_L(0); PG8_MMA(0, 0, At, B0); PG8_BAR; PG8_SCHED;
            PG8_LDB(B1, 1, 1); PG8_STAGE(PG8_SB(1, 0), b3, voffB);
            PG8_BAR; PG8_WAIT_L(0); PG8_MMA(0, 1, At, B1); PG8_BAR; PG8_SCHED8;
            PG8_LDA(At, 1, 1); PG8_STAGE(PG8_SA(1, 0), a3, voffA);
            PG8_BAR; PG8_WAIT_L(0); PG8_MMA(1, 0, At, B0); PG8_BAR; PG8_SCHED;
            PG8_STAGE(PG8_SB(1, 1), b3 + hstep, voffB);
            PG8_WAIT_V(6); PG8_BAR; PG8_MMA(1, 1, At, B1); PG8_BAR; PG8_SCHED8;
        }
        if constexpr (EB == 1) asm volatile("s_nop 15\n\ts_nop 15" ::: "memory");
        E(acc, cur, wr, wc, fr, fq);
        if (!has_next) break;
#pragma unroll
        for (int a = 0; a < 2; ++a)
#pragma unroll
            for (int b = 0; b < 2; ++b)
#pragma unroll
                for (int m = 0; m < 4; ++m)
#pragma unroll
                    for (int n = 0; n < 2; ++n) acc[a][b][m][n] = (f32x4){0.f, 0.f, 0.f, 0.f};
        cur = nxt; cA = nA; cB = nB; ++ui;
    }
    PG8_WAIT_V(0);
    if (wr == 0) PG8_BAR;
    PG8_BAR;
#undef PG8_SA
#undef PG8_SB
#undef PG8_STAGE
#undef PG8_LDA
#undef PG8_LDB
#undef PG8_MMA
#undef PG8_CAT8
#undef PG8_WAIT_V
#undef PG8_WAIT_L
#undef PG8_BAR
#undef PG8_SCHED
}
}
struct Params { const float* in[46]; float* out; unsigned char* ws; };
enum { I_X = 0, I_C, I_CTX, I_CCTX, I_ADAW, I_ADAB, I_NORMG, I_GWIN, I_GGV, I_GWS, I_GBS, I_GWOUT, I_LWIN, I_LCW, I_LCB, I_LWA, I_LBA, I_LWX, I_LBX, I_LLAM, I_LWOUT,
       I_HWIN, I_HCW, I_HCB, I_HFW1, I_HFB1, I_HFW2, I_HFB2, I_HFW3, I_HFB3, I_HFREQ, I_HFWOUT, I_HBIAS, I_HWOUT, I_PWIN, I_PWG, I_PBG, I_PSCALE, I_PWOUT,
       I_FWG, I_FWU, I_FWD, I_MWR, I_MWG, I_MWU, I_MWD };

struct Frame {
    LAS unsigned char* lds; int tid, lane, wave, G, vcu; const Params* P; unsigned char* ws;
};

__device__ __forceinline__ int fresh_tid_w(int wave) { return wave * 64 + lane_now(); }
__device__ __forceinline__ void ld_f32row(const float* p, int lane, f32x4 (&v)[4]) {
#pragma unroll
    for (int j = 0; j < 4; ++j) v[j] = *(const f32x4*)(p + 4 * lane + 256 * j);
}
__device__ __forceinline__ void st_f32row(float* p, int lane, const f32x4 (&v)[4]) {
#pragma unroll
    for (int j = 0; j < 4; ++j) *(f32x4*)(p + 4 * lane + 256 * j) = v[j];
}
__device__ __forceinline__ void ld_bf16row(const bf16_t* p, int lane, f32x4 (&v)[4]) {
#pragma unroll
    for (int j = 0; j < 4; ++j) { const u32x2 w = *(const u32x2*)(p + 4 * lane + 256 * j); v[j] = (f32x4){bflo(w.x), bfhi(w.x), bflo(w.y), bfhi(w.y)}; }
}
__device__ __forceinline__ void st_bf16row(bf16_t* p, int lane, const f32x4 (&v)[4]) {
#pragma unroll
    for (int j = 0; j < 4; ++j) { u32x2 w; w.x = pk2(v[j][0], v[j][1]); w.y = pk2(v[j][2], v[j][3]); *(u32x2*)(p + 4 * lane + 256 * j) = w; }
}
__device__ __forceinline__ float row_sumsq(const f32x4 (&v)[4]) {
    float s = 0.f;
#pragma unroll
    for (int j = 0; j < 4; ++j) s += (v[j][0] * v[j][0] + v[j][1] * v[j][1]) + (v[j][2] * v[j][2] + v[j][3] * v[j][3]);
    return wave_sum(s);
}

__device__ __forceinline__ void transpose_item(const float* W, int K, int N, bf16_t* WT, int k0, int n0, int drow0, LAS float* scr, int lane) {
#pragma unroll 8
    for (int i = 0; i < 32; ++i) { const int kk = 2 * i + (lane >> 5); scr[kk * 33 + (lane & 31)] = W[(size_t)(k0 + kk) * N + n0 + (lane & 31)]; }
    LDS_WAIT(); asm volatile("" ::: "memory");
    const int c = lane & 7;
#pragma unroll
    for (int j = 0; j < 4; ++j) { const int n = (lane >> 3) + 8 * j; const LAS float* s = scr + (8 * c) * 33 + n;
        u32x4 o; o.x = pk2(s[0 * 33], s[1 * 33]); o.y = pk2(s[2 * 33], s[3 * 33]); o.z = pk2(s[4 * 33], s[5 * 33]); o.w = pk2(s[6 * 33], s[7 * 33]);
        *(u32x4*)(WT + (size_t)(drow0 + n) * K + k0 + 8 * c) = o; }
    LDS_WAIT(); asm volatile("" ::: "memory");
}
__device__ __forceinline__ void conv_generic(const float* src, int K, int N, bf16_t* dst, int mode, int item, LAS float* scr, int lane) {
    const int nblk = N / 32, kb = item / nblk, nb = item % nblk, k0 = 64 * kb, n0 = 32 * nb;
    const int drow0 = mode == 0 ? n0 : (256 * (n0 >> 7) + (n0 & 127) + (mode == 2 ? 128 : 0));
    transpose_item(src, K, N, dst, k0, n0, drow0, scr, lane);
}
__device__ __forceinline__ void transpose_item8(const float* W, int K, int N, unsigned char* WT, int k0, int n0, int drow0, float wscale, LAS float* scr, int lane) {
    float v[32]; const float* wp = W + (size_t)(k0 + (lane >> 5)) * N + n0 + (lane & 31);
#pragma unroll
    for (int i = 0; i < 32; ++i) v[i] = wp[(size_t)(2 * i) * N];
#pragma unroll
    for (int i = 0; i < 32; ++i) scr[(2 * i + (lane >> 5)) * 33 + (lane & 31)] = v[i];
    LDS_WAIT(); asm volatile("" ::: "memory");
    const int c = lane & 7;
#pragma unroll
    for (int j = 0; j < 4; ++j) { const int n = (lane >> 3) + 8 * j; const LAS float* s = scr + (8 * c) * 33 + n;
        u32x2 o; o.x = pk4_fp8(s[0 * 33] * wscale, s[1 * 33] * wscale, s[2 * 33] * wscale, s[3 * 33] * wscale); o.y = pk4_fp8(s[4 * 33] * wscale, s[5 * 33] * wscale, s[6 * 33] * wscale, s[7 * 33] * wscale);
        *(u32x2*)(WT + (size_t)(drow0 + n) * K + k0 + 8 * c) = o; }
    LDS_WAIT(); asm volatile("" ::: "memory");
}
__device__ __forceinline__ void conv_generic8(const float* src, int K, int N, unsigned char* dst, int mode, int item, float wscale, LAS float* scr, int lane) {
    const int nblk = N / 32, kb = item / nblk, nb = item % nblk, k0 = 64 * kb, n0 = 32 * nb;
    const int drow0 = mode == 0 ? n0 : (256 * (n0 >> 7) + (n0 & 127) + (mode == 2 ? 128 : 0));
    transpose_item8(src, K, N, dst, k0, n0, drow0, wscale, scr, lane);
}
#ifndef FFN8_MASK
#define FFN8_MASK 2
#endif
#ifndef PIN8
#define PIN8 1
#endif
#ifndef LIN8
#define LIN8 0
#endif
#ifndef HIN8
#define HIN8 1
#endif
constexpr int FFN_SA1 = 3, FFN_SB1 = 6, FFN_SA2 = 2, FFN_SB2 = 7;
constexpr int NCONV_SMALL = 2048 + 1024 + 1024 + 512 + 1536 + 512 + 512 + 512 + 6 * 1408;
constexpr int NCONV_MOE = 8 * 3 * 1792;
__device__ __forceinline__ void conv_small_item(const Frame& F, int it, LAS float* scr) {
    const Params& P = *F.P; unsigned char* ws = F.ws; int r = it;
    if (r < 2048) { conv_generic(P.in[I_GWIN], 1024, 4096, (bf16_t*)(ws + W_GIN), 0, r, scr, F.lane); return; } r -= 2048;
    if (r < 1024) { conv_generic(P.in[I_GWOUT], 2048, 1024, (bf16_t*)(ws + W_GOUT), 0, r, scr, F.lane); return; } r -= 1024;
    if (r < 1024) { if (LIN8) conv_generic8(P.in[I_LWIN], 1024, 2048, ws + W_LIN, 0, r, (float)(1 << FFN_SB1), scr, F.lane); else conv_generic(P.in[I_LWIN], 1024, 2048, (bf16_t*)(ws + W_LIN), 0, r, scr, F.lane); return; } r -= 1024;
    if (r < 512) { conv_generic(P.in[I_LWOUT], 1024, 1024, (bf16_t*)(ws + W_LOUT), 0, r, scr, F.lane); return; } r -= 512;
    if (r < 1536) { if (HIN8) conv_generic8(P.in[I_HWIN], 1024, 3072, ws + W_HIN, 0, r, (float)(1 << FFN_SB1), scr, F.lane); else conv_generic(P.in[I_HWIN], 1024, 3072, (bf16_t*)(ws + W_HIN), 0, r, scr, F.lane); return; } r -= 1536;
    if (r < 512) { conv_generic(P.in[I_HWOUT], 1024, 1024, (bf16_t*)(ws + W_HOUT), 0, r, scr, F.lane); return; } r -= 512;
    if (r < 512) { if (PIN8) conv_generic8(P.in[I_PWIN], 1024, 1024, ws + W_PIN, 0, r, (float)(1 << FFN_SB1), scr, F.lane); else conv_generic(P.in[I_PWIN], 1024, 1024, (bf16_t*)(ws + W_PIN), 0, r, scr, F.lane); return; } r -= 512;
    if (r < 512) { conv_generic(P.in[I_PWOUT], 1024, 1024, (bf16_t*)(ws + W_POUT), 0, r, scr, F.lane); return; } r -= 512;
    const int which = r / 2816, rr = r % 2816, l = rr / 1408, item = rr % 1408;
    if ((FFN8_MASK >> l) & 1) {
        unsigned char* gu8 = ws + W_FGU + (size_t)l * 11 * MiB; unsigned char* d8 = ws + W_FD + (size_t)l * 11 * MiB / 2;
        if (which == 0) conv_generic8(P.in[I_FWG] + (size_t)l * 1024 * DFF, 1024, DFF, gu8, 1, item, (float)(1 << FFN_SB1), scr, F.lane);
        else if (which == 1) conv_generic8(P.in[I_FWU] + (size_t)l * 1024 * DFF, 1024, DFF, gu8, 2, item, (float)(1 << FFN_SB1), scr, F.lane);
        else conv_generic8(P.in[I_FWD] + (size_t)l * DFF * 1024, DFF, 1024, d8, 0, item, (float)(1 << FFN_SB2), scr, F.lane);
    } else {
        bf16_t* gu = (bf16_t*)(ws + W_FGU + (size_t)l * 11 * MiB); bf16_t* dd = (bf16_t*)(ws + W_FD + (size_t)l * 11 * MiB / 2);
        if (which == 0) conv_generic(P.in[I_FWG] + (size_t)l * 1024 * DFF, 1024, DFF, gu, 1, item, scr, F.lane);
        else if (which == 1) conv_generic(P.in[I_FWU] + (size_t)l * 1024 * DFF, 1024, DFF, gu, 2, item, scr, F.lane);
        else conv_generic(P.in[I_FWD] + (size_t)l * DFF * 1024, DFF, 1024, dd, 0, item, scr, F.lane);
    }
}
static_assert(true, ""); constexpr int MOE_SA1 = 3, MOE_SB1 = 6, MOE_SA2 = 2, MOE_SB2 = 7;
constexpr size_t WM_LAYER = 84 * MiB, WM_DOFF = 56 * MiB;
__device__ __forceinline__ void conv_moe_item(const Frame& F, int layer, int it, LAS float* scr) {
    const Params& P = *F.P; unsigned char* ws = F.ws;
    const int e = it / 5376, r = it % 5376, which = r / 1792, item = r % 1792; const size_t eo = (size_t)(layer * NEXP + e);
    unsigned char* gu = ws + WS_WMOE + (size_t)layer * WM_LAYER + (size_t)e * 2 * EFF * 1024; unsigned char* dd = ws + WS_WMOE + (size_t)layer * WM_LAYER + WM_DOFF + (size_t)e * 1024 * EFF;
    if (which == 0) conv_generic8(P.in[I_MWG] + eo * 1024 * EFF, 1024, EFF, gu, 1, item, (float)(1 << MOE_SB1), scr, F.lane);
    else if (which == 1) conv_generic8(P.in[I_MWU] + eo * 1024 * EFF, 1024, EFF, gu, 2, item, (float)(1 << MOE_SB1), scr, F.lane);
    else conv_generic8(P.in[I_MWD] + eo * EFF * 1024, EFF, 1024, dd, 0, item, (float)(1 << MOE_SB2), scr, F.lane);
}
#ifndef SLQ0
#define SLQ0 0
#define SLQ1 0
#define SLQ2 0
#define SLQ3 0
#define SLQ4 0
#define SLQ5 0
#endif
constexpr int SL_Q[6] = {SLQ0, SLQ1, SLQ2, SLQ3, SLQ4, SLQ5};
constexpr int SL_FIRST[6] = {(MT / 256 * 16) % 256, (MT / 256 * 4) % 256, (MT / 256 * 22) % 256, (MT / 256 * 4) % 256, (MT / 256 * 8) % 256, 8};
constexpr int sl_base(int s) { int b = 0; for (int i = 0; i < s; ++i) b += (256 - SL_FIRST[i]) * 8 * SL_Q[i]; return b; }
constexpr int SL_TOTAL = sl_base(6) < 2 * NCONV_MOE ? sl_base(6) : 2 * NCONV_MOE;
__device__ __forceinline__ void conv_slot(const Frame& F0, int s, int rank  ) {
    Frame F = F0; F.tid = fresh_tid_w(F0.wave); F.lane = F.tid & 63;
    LAS float* scr = (LAS float*)(F.lds + F.wave * 16384);
    const int base = sl_base(s), q = SL_Q[s], nw = (256 - SL_FIRST[s]) * 8, w = rank * 8 + F.wave;
    for (int n = 0; n < q; ++n) { const int it = base + n * nw + w;
        if (it < 2 * NCONV_MOE) conv_moe_item(F, it >= NCONV_MOE ? 1 : 0, it >= NCONV_MOE ? it - NCONV_MOE : it, scr); }
}
__device__ __forceinline__ int qperm(int n) { return (((n & 31) << 5) + ((n >> 5) & 31)) * 32 + (n >> 10); }

__device__ __forceinline__ void p0_prologue(const Frame& F0) {
    Frame F = F0; F.tid = fresh_tid_w(F0.wave); F.lane = F.tid & 63;
    const Params& P = *F.P; unsigned char* ws = F.ws;
    const int gw = F.vcu * NWAVES + F.wave, NGW = F.G * NWAVES; const int lane = F.lane;
    {
        LAS float* sv = (LAS float*)(F.lds);
        LAS float* red = (LAS float*)(F.lds + 16384);
        for (int i = F.tid; i < 3 * 1024; i += NTHR) { const int r = i >> 10, k = i & 1023; const float v = r < 2 ? P.in[I_C][r * 1024 + k] : P.in[I_CCTX][k]; sv[i] = siluf_(v); }
        __syncthreads();
        for (int unit = F.vcu; unit < 4 * 48; unit += F.G) {
            const int li = unit / 48, col0 = (unit % 48) * 128; const int kp = F.tid >> 5, n4 = F.tid & 31;
            f32x4 a0 = {0.f, 0.f, 0.f, 0.f}, a1 = a0, a2 = a0;
            const float* wp = P.in[I_ADAW] + ((size_t)li * 1024 + kp * 64) * 6144 + col0 + 4 * n4;
#pragma unroll 8
            for (int k = 0; k < 64; ++k) { const f32x4 w = *(const f32x4*)(wp + (size_t)k * 6144); const int kk = kp * 64 + k;
                a0 += w * sv[kk]; a1 += w * sv[1024 + kk]; a2 += w * sv[2048 + kk]; }
            *(LAS f32x4*)(red + (kp * 3 + 0) * 128 + 4 * n4) = a0; *(LAS f32x4*)(red + (kp * 3 + 1) * 128 + 4 * n4) = a1; *(LAS f32x4*)(red + (kp * 3 + 2) * 128 + 4 * n4) = a2;
            __syncthreads();
            if (F.tid < 384) { const int r = F.tid >> 7, cc = F.tid & 127; float s = P.in[I_ADAB][li * 6144 + col0 + cc];
#pragma unroll
                for (int p = 0; p < 16; ++p) s += red[(p * 3 + r) * 128 + cc];
                ((float*)(ws + WS_MOD))[((size_t)li * 3 + r) * 6144 + col0 + cc] = s; }
            __syncthreads();
        }
    }
    {
        float* pe = (float*)(ws + WS_PE);
        for (int i = (F.vcu * NTHR + F.tid); i < 320 * 512; i += F.G * NTHR) { const int p = i >> 9, j = i & 511, k = j & 255;
            const float omega = 1.0f / powf(10000.0f, (float)k / 256.0f); const float pos = (float)(p < 256 ? p : p - 256); const float ang = pos * omega;
            pe[i] = (j < 256) ? sinf(ang) : cosf(ang); }
    }
    {
        const int gt = F.vcu * NTHR + F.tid, NGT = F.G * NTHR;
        bf16_t* ws16 = (bf16_t*)(ws + WS_WS16);
        for (int i = gt; i < 8 * 128 * 128; i += NGT) ws16[i] = (bf16_t)f2bf(P.in[I_GWS][i]);
        bf16_t* lw = (bf16_t*)(ws + WS_LRUW);
        for (int i = gt; i < 8 * 512 * 128; i += NGT) { const int k = i & 127, R = (i >> 7) & 511, h = i >> 16; const int jb = R >> 6, nt = (R >> 4) & 3, jj = R & 15, j = 16 * jb + jj;
            const float* src = (nt & 1) ? P.in[I_LWX] : P.in[I_LWA]; const int dir = nt >> 1;
            lw[i] = (bf16_t)f2bf(src[(((size_t)dir * 8 + h) * 128 + k) * 128 + j]); }
        bf16_t* pw = (bf16_t*)(ws + WS_POOLW);
        for (int i = gt; i < 4 * 256 * 256; i += NGT) { const int c = i & 255, d = (i >> 8) & 255, g = i >> 16; pw[i] = (bf16_t)f2bf(P.in[I_PWG][((size_t)g * 256 + c) * 256 + d]); }
        bf16_t* hw = (bf16_t*)(ws + WS_HYW);
        for (int i = gt; i < 2048 * 256; i += NGT) { const int k = i & 255, row = i >> 8, o = row >> 10, ch = row & 1023;
            float v = 0.f; if (k < 128) v = P.in[I_HFWOUT][(size_t)(k & 63) * 4096 + o * 2048 + (k >> 6) * 1024 + ch]; hw[i] = (bf16_t)f2bf(v); }
    }
    {
        bf16_t* hq = (bf16_t*)(ws + WS_HQ);
        const float* w1 = P.in[I_HFW1]; const float* b1 = P.in[I_HFB1]; const float* w2 = P.in[I_HFW2]; const float* b2 = P.in[I_HFB2]; const float* w3 = P.in[I_HFW3]; const float* b3 = P.in[I_HFB3]; const float* fq = P.in[I_HFREQ];
        for (int t = gw; t < SEQ; t += NGW) {
            const float tn = (float)t * (1.0f / 16383.0f); const float wt = 6.283185307179586f * (float)t / 16384.0f;
            float zv = 0.f;
            if (lane == 0) zv = tn;
            else if (lane <= 32) { const int b = (lane - 1) & 15; const float band = 1e-4f + (float)b * ((15.0f - 1e-4f) / 15.0f); const float a = band * wt; zv = (lane <= 16) ? cosf(a) : sinf(-a); }
            float acc = b1[lane];
#pragma unroll
            for (int i = 0; i < 33; ++i) acc += __shfl(zv, i) * w1[i * 64 + lane];
            float h = sinf(fq[lane] * acc);
            acc = b2[lane];
#pragma unroll 16
            for (int i = 0; i < 64; ++i) acc += __shfl(h, i) * w2[i * 64 + lane];
            h = sinf(fq[64 + lane] * acc);
            acc = b3[lane];
#pragma unroll 16
            for (int i = 0; i < 64; ++i) acc += __shfl(h, i) * w3[i * 64 + lane];
            h = sinf(fq[128 + lane] * acc);
            const int src = 4 * (lane & 15);
            const float h0 = __shfl(h, src), h1 = __shfl(h, src + 1), h2 = __shfl(h, src + 2), h3 = __shfl(h, src + 3);
            u32x2 val; val.x = pk2(h0, h1); val.y = pk2(h2, h3); const u32x2 zero = {0u, 0u};
            *(u32x2*)(hq + (size_t)qperm(t) * 256 + 4 * lane) = (lane < 16) ? val : zero;
            if (t >= 1) *(u32x2*)(hq + (size_t)qperm(32768 - t) * 256 + 4 * lane) = (lane >= 16 && lane < 32) ? val : zero;
            else *(u32x2*)(hq + (size_t)qperm(16384) * 256 + 4 * lane) = zero;
        }
    }
    {
        LAS float* scr = (LAS float*)(F.lds + 32768 + F.wave * 8704);
        __syncthreads();
        for (int it = gw; it < NCONV_SMALL; it += NGW) conv_small_item(F, it, scr);
        for (int it = (F.G == 256 ? SL_TOTAL : 0) + gw; it < 2 * NCONV_MOE; it += NGW) conv_moe_item(F, it >= NCONV_MOE ? 1 : 0, it >= NCONV_MOE ? it - NCONV_MOE : it, scr);
    }
}
__device__ __forceinline__ void ld_vec(const float* p, int lane, f32x4 (&v)[4]) { ld_f32row(p, lane, v); }

__device__ __forceinline__ void norm1_phase(const Frame& F0) {
    Frame F = F0; F.tid = fresh_tid_w(F0.wave); F.lane = F.tid & 63;
    const Params& P = *F.P; unsigned char* ws = F.ws; const int lane = F.lane;
    const float* mod = (const float*)(ws + WS_MOD); const float* pe = (const float*)(ws + WS_PE); bf16_t* H = (bf16_t*)(ws + WS_H);
    f32x4 g[4]; ld_vec(P.in[I_NORMG], lane, g);
    for (int blk = F.vcu; blk < 256; blk += F.G) {
        {
            const int row0 = blk * 128 + F.wave * 16, b = row0 >> 14;
            f32x4 sh[4], sc[4]; ld_vec(mod + (size_t)b * 6144, lane, sh); ld_vec(mod + (size_t)b * 6144 + 1024, lane, sc);
            f32x4 qx[2][4], qp[2][4];
#define N1_ISSUE(i_, s_) do { const int m_ = row0 + (i_), t_ = m_ & 16383, r_ = t_ >> 6, c_ = t_ & 63; ld_f32row(P.in[I_X] + (size_t)m_ * D, lane, qx[s_]); \
                qp[s_][0] = *(const f32x4*)(pe + r_ * 512 + 4 * lane); qp[s_][1] = *(const f32x4*)(pe + r_ * 512 + 256 + 4 * lane); \
                qp[s_][2] = *(const f32x4*)(pe + (256 + c_) * 512 + 4 * lane); qp[s_][3] = *(const f32x4*)(pe + (256 + c_) * 512 + 256 + 4 * lane); } while (0)
#define N1_BODY(i_, s_) do { const int m = row0 + (i_); f32x4 x[4]; \
                _Pragma("unroll") for (int j = 0; j < 4; ++j) x[j] = qx[s_][j] + qp[s_][j]; \
                if ((i_) + 2 < 16) N1_ISSUE((i_) + 2, s_); \
                asm volatile("" ::: "memory"); \
                st_bf16row((bf16_t*)(ws + WS_XB) + (size_t)m * D, lane, x); \
                const float rr = rsqrtf(row_sumsq(x) * (1.0f / D) + EPS); \
                _Pragma("unroll") for (int j = 0; j < 4; ++j) x[j] = (x[j] * rr * g[j]) * (1.0f + sc[j]) + sh[j]; \
                st_bf16row(H + (size_t)m * D, lane, x); } while (0)
            N1_ISSUE(0, 0); N1_ISSUE(1, 1);
#pragma unroll 1
            for (int i = 0; i < 16; i += 2) { N1_BODY(i, 0); N1_BODY(i + 1, 1); }
        }
        const int gwi = blk * 8 + F.wave;
        if (gwi < 32) {
            f32x4 sh[4], sc[4]; ld_vec(mod + (size_t)2 * 6144, lane, sh); ld_vec(mod + (size_t)2 * 6144 + 1024, lane, sc);
            for (int i = 0; i < 16; ++i) { const int m = gwi * 16 + i;
                f32x4 x[4]; ld_f32row(P.in[I_CTX] + (size_t)m * D, lane, x);
                st_f32row((float*)(ws + WS_XC) + (size_t)m * D, lane, x);
                const float rr = rsqrtf(row_sumsq(x) * (1.0f / D) + EPS);
#pragma unroll
                for (int j = 0; j < 4; ++j) x[j] = (x[j] * rr * g[j]) * (1.0f + sc[j]) + sh[j];
                st_bf16row(H + (size_t)(ML + m) * D, lane, x); }
        }
    }
}

__device__ __forceinline__ void st_fp8row(unsigned char* p, int lane, const f32x4 (&v)[4], float sc) {
#pragma unroll
    for (int j = 0; j < 4; ++j) *(unsigned*)(p + 4 * lane + 256 * j) = pk4_fp8(v[j][0] * sc, v[j][1] * sc, v[j][2] * sc, v[j][3] * sc);
}
template <bool HAS_NEXT, bool H8, bool X16>
__device__ __forceinline__ void post_row(const bool dry, f32x4 (&y)[4], f32x4 (&x)[4], float* xrow, bf16_t* hrow, int lane, const f32x4 (&gA)[4], const f32x4 (&gate)[4], const f32x4 (&gB)[4], const f32x4 (&sc)[4], const f32x4 (&sh)[4], f32x4 (&hf)[4]) {
    const float ry = rsqrtf(row_sumsq(y) * (1.0f / D) + EPS);
#pragma unroll
    for (int j = 0; j < 4; ++j) x[j] += gate[j] * (y[j] * ry * gA[j]);
    if (!dry) { if (X16) st_bf16row((bf16_t*)xrow, lane, x); else st_f32row(xrow, lane, x); }
    if (HAS_NEXT) {
        const float rx = rsqrtf(row_sumsq(x) * (1.0f / D) + EPS);
#pragma unroll
        for (int j = 0; j < 4; ++j) hf[j] = (x[j] * rx * gB[j]) * (1.0f + sc[j]) + sh[j];
        if (!dry) { if (H8) st_fp8row((unsigned char*)hrow, lane, hf, (float)(1 << FFN_SA1)); else st_bf16row(hrow, lane, hf); }
    }
}

__device__ __forceinline__ void post_route(const bool dry, const f32x4 (&hf)[4], const LAS float* wr, LAS int* hist, unsigned* rt, int lane) {
    float lg[8];
#pragma unroll
    for (int e = 0; e < 8; ++e) lg[e] = 0.f;
#pragma unroll
    for (int j = 0; j < 4; ++j)
#pragma unroll
        for (int r = 0; r < 4; ++r) { const LAS float* wp = wr + (lane + 64 * j) * 36 + r * 8; const f32x4 w0 = *(const LAS f32x4*)wp, w1 = *(const LAS f32x4*)(wp + 4); const float hv = hf[j][r];
            lg[0] += hv * w0[0]; lg[1] += hv * w0[1]; lg[2] += hv * w0[2]; lg[3] += hv * w0[3]; lg[4] += hv * w1[0]; lg[5] += hv * w1[1]; lg[6] += hv * w1[2]; lg[7] += hv * w1[3]; }
#pragma unroll
    for (int e = 0; e < 8; ++e) lg[e] = wave_sum(lg[e]);
    int e0 = 0; float v0 = lg[0];
#pragma unroll
    for (int e = 1; e < 8; ++e) if (lg[e] > v0) { v0 = lg[e]; e0 = e; }
    int e1 = -1; float v1 = -3.0e38f;
#pragma unroll
    for (int e = 0; e < 8; ++e) if (e != e0 && lg[e] > v1) { v1 = lg[e]; e1 = e; }
    const float p1 = 1.0f / (1.0f + __expf(v0 - v1)), p0 = 1.0f - p1;
    if (lane == 0 && !dry) { rt[0] = (unsigned)e0 | ((unsigned)e1 << 8); rt[1] = __builtin_bit_cast(unsigned, p0); rt[2] = __builtin_bit_cast(unsigned, p1);
        __hip_atomic_fetch_add(&hist[e0], 1, __ATOMIC_RELAXED, __HIP_MEMORY_SCOPE_WORKGROUP); __hip_atomic_fetch_add(&hist[e1], 1, __ATOMIC_RELAXED, __HIP_MEMORY_SCOPE_WORKGROUP); }
}

template <bool MOE_IN, bool ROUTE, bool HAS_NEXT, bool DO_CTX, bool H8 = false, bool FIRSTX = false>
__device__ __forceinline__ void post_phase(const Frame& F0, int li, int sub, const bool dry = false) {
    Frame F = F0; F.tid = fresh_tid_w(F0.wave); F.lane = F.tid & 63;
    const Params& P = *F.P; unsigned char* ws = F.ws; const int lane = F.lane;
    const float* mod = (const float*)(ws + WS_MOD); bf16_t* H = (bf16_t*)(ws + WS_H); const bf16_t* Y = (const bf16_t*)(ws + WS_Y);
    unsigned* route = (unsigned*)(ws + WS_ROUTE);
    const int ka = sub == 1 ? 1 : 3, gate_off = sub == 1 ? 2048 : 5120;
    const int li2 = sub == 1 ? li : li + 1, kb = sub == 1 ? 2 : 0, sh_off = sub == 1 ? 3072 : 0, sc_off = sub == 1 ? 4096 : 1024;
    f32x4 gA[4], gB[4]; ld_vec(P.in[I_NORMG] + (size_t)(li * 4 + ka) * D, lane, gA);
    if (HAS_NEXT) ld_vec(P.in[I_NORMG] + (size_t)(li2 * 4 + kb) * D, lane, gB);
    LAS float* wr = (LAS float*)(F.lds);
    LAS int* hist = (LAS int*)(F.lds + 40960);
    if (ROUTE) {
        const float* src = P.in[I_MWR] + (size_t)(li >> 1) * 1024 * 8;
        for (int i = F.tid; i < 8192; i += NTHR) wr[(i >> 5) * 36 + (i & 31)] = src[i];
        __syncthreads();
    }
    for (int blk = F.vcu; blk < 256; blk += F.G) {
        if (ROUTE) { if (F.tid < 8) hist[F.tid] = 0; __syncthreads(); }
        {
            const int row0 = blk * 128 + F.wave * 16, b = row0 >> 14;
            f32x4 gate[4], sc[4], sh[4]; ld_vec(mod + ((size_t)li * 3 + b) * 6144 + gate_off, lane, gate);
            if (HAS_NEXT) { ld_vec(mod + ((size_t)li2 * 3 + b) * 6144 + sc_off, lane, sc); ld_vec(mod + ((size_t)li2 * 3 + b) * 6144 + sh_off, lane, sh); }
            bf16_t* XB = (bf16_t*)(ws + WS_XB);
            unsigned rc1 = 0u, rc2 = 0u, rc3 = 0u, rc4 = 0u;
            if (MOE_IN) { const unsigned* rt_ = route + (size_t)(row0 + (lane & 15)) * 8; rc1 = rt_[1]; rc2 = rt_[2]; rc3 = rt_[3]; rc4 = rt_[4]; }
            constexpr int PD = (MOE_IN || ROUTE) ? 3 : 4;
            u32x2 qy[4][4], qz[4][4], qx[4][4]; float qp0[4], qp1[4];
#define POST_LDRAW(p_, q_) do { _Pragma("unroll") for (int j_ = 0; j_ < 4; ++j_) q_[j_] = *(const u32x2*)((p_) + 4 * lane + 256 * j_); } while (0)
#define POST_ISSUE(i_, s_) do { const int m_ = row0 + (i_); \
                if (MOE_IN) { qp0[s_] = __builtin_bit_cast(float, __builtin_amdgcn_readlane(rc1, (i_))); qp1[s_] = __builtin_bit_cast(float, __builtin_amdgcn_readlane(rc2, (i_))); \
                    const unsigned a_ = __builtin_amdgcn_readlane(rc3, (i_)), b_ = __builtin_amdgcn_readlane(rc4, (i_)); POST_LDRAW(Y + (size_t)a_ * D, qy[s_]); POST_LDRAW(Y + (size_t)b_ * D, qz[s_]); } \
                else POST_LDRAW(Y + (size_t)m_ * D, qy[s_]); \
                POST_LDRAW(XB + (size_t)m_ * D, qx[s_]); } while (0)
#define POST_BODY(i_, s_) do { const int m = row0 + (i_); f32x4 y[4], x[4], hf[4]; \
                _Pragma("unroll") for (int j = 0; j < 4; ++j) { \
                    if (MOE_IN) y[j] = (f32x4){qp0[s_] * bflo(qy[s_][j].x) + qp1[s_] * bflo(qz[s_][j].x), qp0[s_] * bfhi(qy[s_][j].x) + qp1[s_] * bfhi(qz[s_][j].x), qp0[s_] * bflo(qy[s_][j].y) + qp1[s_] * bflo(qz[s_][j].y), qp0[s_] * bfhi(qy[s_][j].y) + qp1[s_] * bfhi(qz[s_][j].y)}; \
                    else y[j] = (f32x4){bflo(qy[s_][j].x), bfhi(qy[s_][j].x), bflo(qy[s_][j].y), bfhi(qy[s_][j].y)}; \
                    x[j] = (f32x4){bflo(qx[s_][j].x), bfhi(qx[s_][j].x), bflo(qx[s_][j].y), bfhi(qx[s_][j].y)}; } \
                if ((i_) + PD < 16) POST_ISSUE((i_) + PD, s_); \
                asm volatile("" ::: "memory");                        \
                post_row<HAS_NEXT, H8, HAS_NEXT>(dry, y, x, HAS_NEXT ? (float*)(XB + (size_t)m * D) : P.out + (size_t)m * D, H8 ? (bf16_t*)((unsigned char*)H + (size_t)m * D) : H + (size_t)m * D, lane, gA, gate, gB, sc, sh, hf); \
                if (ROUTE) post_route(dry, hf, wr, hist, route + (size_t)m * 8, lane); } while (0)
            POST_ISSUE(0, 0); POST_ISSUE(1, 1); if (PD > 2) POST_ISSUE(2, 2); if (PD > 3) POST_ISSUE(3, 3);
#pragma unroll 1
            for (int i = 0; i < 16; i += PD) { POST_BODY(i, 0); if (i + 1 < 16) POST_BODY(i + 1, 1); if (PD > 2 && i + 2 < 16) POST_BODY(i + 2, 2); if (PD > 3) POST_BODY(i + 3, 3); }
        }
        if (DO_CTX) { const int gwi = blk * 8 + F.wave;
            if (gwi < 32) {
                f32x4 gate[4], sc[4], sh[4]; ld_vec(mod + ((size_t)li * 3 + 2) * 6144 + gate_off, lane, gate);
                if (HAS_NEXT) { ld_vec(mod + ((size_t)li2 * 3 + 2) * 6144 + sc_off, lane, sc); ld_vec(mod + ((size_t)li2 * 3 + 2) * 6144 + sh_off, lane, sh); }
                for (int i = 0; i < 16; ++i) { const int m = gwi * 16 + i; f32x4 y[4], x[4], hf[4]; ld_bf16row(Y + (size_t)(ML + m) * D, lane, y); ld_f32row((float*)(ws + WS_XC) + (size_t)m * D, lane, x);
                    post_row<HAS_NEXT, H8, false>(dry, y, x, (float*)(ws + WS_XC) + (size_t)m * D, H8 ? (bf16_t*)((unsigned char*)H + (size_t)(ML + m) * D) : H + (size_t)(ML + m) * D, lane, gA, gate, gB, sc, sh, hf); }
            } }
        if (ROUTE) { __syncthreads(); if (F.tid < 8 && !dry) ((int*)(ws + WS_COUNTS))[blk * 8 + F.tid] = hist[F.tid]; __syncthreads(); }
    }
}

__device__ __forceinline__ void vstats_phase(const Frame& F0) {
    Frame F = F0; F.tid = fresh_tid_w(F0.wave); F.lane = F.tid & 63;
    const bf16_t* UV = (const bf16_t*)(F.ws + WS_BIG); float* st = (float*)(F.ws + WS_ROWSTAT);
    const int gw = F.vcu * NWAVES + F.wave, NGW = F.G * NWAVES;
    for (int m0 = gw; m0 < MT; m0 += 4 * NGW) {
        u32x4 w[4][4];
#pragma unroll
        for (int r = 0; r < 4; ++r) { int m = m0 + r * NGW; m = m < MT ? m : MT - 1; const bf16_t* p = UV + (size_t)m * 4096 + 2048 + 8 * F.lane;
#pragma unroll
            for (int j = 0; j < 4; ++j) w[r][j] = *(const u32x4*)(p + 512 * j); }
        asm volatile("" ::: "memory");
#pragma unroll
        for (int r = 0; r < 4; ++r) { const int m = m0 + r * NGW; float s = 0.f, q = 0.f;
#pragma unroll
            for (int j = 0; j < 4; ++j)
#pragma unroll
                for (int k = 0; k < 4; ++k) { const float a = bflo(w[r][j][k]), b = bfhi(w[r][j][k]); s += a + b; q += a * a + b * b; }
            s = wave_sum(s); q = wave_sum(q); const float mu = s * (1.0f / 2048.0f); const float var = fmaxf(q * (1.0f / 2048.0f) - mu * mu, 0.f);
            if (F.lane == 0 && m < MT) { st[2 * m] = mu; st[2 * m + 1] = rsqrtf(var + EPS); } } }
}

__device__ __forceinline__ void spatial_phase(const Frame& F0) {
    Frame F = F0; F.tid = fresh_tid_w(F0.wave); F.lane = F.tid & 63;
    const Params& P = *F.P; unsigned char* ws = F.ws; const int tid = F.tid, lane = F.lane, w = F.wave, fr = lane & 15, fq = lane >> 4;
    const bf16_t* UV = (const bf16_t*)(ws + WS_BIG); bf16_t* S = (bf16_t*)(ws + WS_BIG + 260 * MiB); const bf16_t* WS16 = (const bf16_t*)(ws + WS_WS16); const float* st = (const float*)(ws + WS_ROWSTAT);
    LAS unsigned char* ldsA = F.lds; LAS unsigned char* ldsV = F.lds + 34816; LAS float* lst = (LAS float*)(F.lds + 102400);
    int gcache = -1;
    for (int unit = F.vcu; unit < (MT / 128) * 8; unit += F.G) {
        const int chunk = unit >> 3, g = unit & 7, row0 = chunk * 128;
        if (g != gcache) { gcache = g;
#pragma unroll
            for (int i = 0; i < 4; ++i) { const int idx = tid + 512 * i, r = idx >> 4, c16 = idx & 15; *(LAS u32x4*)(ldsA + r * 272 + c16 * 16) = *(const u32x4*)(WS16 + ((size_t)g * 128 + r) * 128 + c16 * 8); } }
#pragma unroll
        for (int i = 0; i < 8; ++i) { const int idx = tid + 512 * i, s = idx >> 5, c8 = idx & 31;
            const u32x4 wv = *(const u32x4*)(UV + (size_t)(row0 + s) * 4096 + 2048 + 256 * g + 8 * c8);
            const float mu = st[2 * (row0 + s)], rs = st[2 * (row0 + s) + 1];
            const f32x4 g0 = *(const f32x4*)(P.in[I_GGV] + 256 * g + 8 * c8), g1 = *(const f32x4*)(P.in[I_GGV] + 256 * g + 8 * c8 + 4);
            u32x4 o; o.x = pk2((bflo(wv.x) - mu) * rs * g0[0], (bfhi(wv.x) - mu) * rs * g0[1]); o.y = pk2((bflo(wv.y) - mu) * rs * g0[2], (bfhi(wv.y) - mu) * rs * g0[3]);
            o.z = pk2((bflo(wv.z) - mu) * rs * g1[0], (bfhi(wv.z) - mu) * rs * g1[1]); o.w = pk2((bflo(wv.w) - mu) * rs * g1[2], (bfhi(wv.w) - mu) * rs * g1[3]);
            *(LAS u32x4*)(ldsV + s * 528 + c8 * 16) = o; }
        __syncthreads();
        u32x2 uq[8][2]; float bsq[8];
#pragma unroll
        for (int m = 0; m < 8; ++m) { const int t = 16 * m + fr; bsq[m] = P.in[I_GBS][g * 128 + t];
#pragma unroll
            for (int n = 0; n < 2; ++n) uq[m][n] = *(const u32x2*)(UV + (size_t)(row0 + t) * 4096 + 256 * g + 32 * w + 16 * n + 4 * fq); }
        asm volatile("" ::: "memory");
        f32x4 acc[8][2];
#pragma unroll
        for (int m = 0; m < 8; ++m) { acc[m][0] = (f32x4){0.f, 0.f, 0.f, 0.f}; acc[m][1] = acc[m][0]; }
#pragma unroll
        for (int ks = 0; ks < 4; ++ks) {
            bf16x8 b[2];
#pragma unroll
            for (int n = 0; n < 2; ++n)
#pragma unroll
                for (int j = 0; j < 8; ++j) b[n][j] = *(const LAS short*)(ldsV + (32 * ks + 8 * fq + j) * 528 + (32 * w + 16 * n + fr) * 2);
#pragma unroll
            for (int m = 0; m < 8; ++m) { const bf16x8 a = *(const LAS bf16x8*)(ldsA + (16 * m + fr) * 272 + ks * 64 + fq * 16);
                acc[m][0] = __builtin_amdgcn_mfma_f32_16x16x32_bf16(b[0], a, acc[m][0], 0, 0, 0); acc[m][1] = __builtin_amdgcn_mfma_f32_16x16x32_bf16(b[1], a, acc[m][1], 0, 0, 0); }
        }
#pragma unroll
        for (int m = 0; m < 8; ++m) { const int t = 16 * m + fr; const size_t row = (size_t)(row0 + t); const float bs = bsq[m];
#pragma unroll
            for (int n = 0; n < 2; ++n) { const int c = 256 * g + 32 * w + 16 * n + 4 * fq; const u32x2 uu = uq[m][n];
                u32x2 o; o.x = pk2((acc[m][n][0] + bs) * bflo(uu.x), (acc[m][n][1] + bs) * bfhi(uu.x)); o.y = pk2((acc[m][n][2] + bs) * bflo(uu.y), (acc[m][n][3] + bs) * bfhi(uu.y));
                *(u32x2*)(S + row * 2048 + c) = o; } }
        __syncthreads();
    }
}
constexpr size_t LRU_LA = 130 * MiB, LRU_BB = 260 * MiB;

__device__ __forceinline__ void lru_gates_phase(const Frame& F0) {
    Frame F = F0; F.tid = fresh_tid_w(F0.wave); F.lane = F.tid & 63;
    const Params& P = *F.P; unsigned char* ws = F.ws; const int w = F.wave;
    const bf16_t* GXB = (const bf16_t*)(ws + WS_BIG); bf16_t* LA = (bf16_t*)(ws + WS_BIG + LRU_LA); bf16_t* BB = (bf16_t*)(ws + WS_BIG + LRU_BB); const bf16_t* LW = (const bf16_t*)(ws + WS_LRUW);
    LAS unsigned char* ldsX = F.lds; LAS unsigned* stg = (LAS unsigned*)(F.lds + 34816); LAS f32x2* hx = (LAS f32x2*)(F.lds + 102400);
    float* AGG = (float*)(ws + WS_AGG);
    LAS float* prm = (LAS float*)(F.lds + 104448);
    int hcache = -1;
    for (int unit = F.vcu; unit < (MT / 128) * 8; unit += F.G) {
        const int tid = fresh_tid_w(w);
        const int lane = tid & 63, fr = lane & 15, fq = lane >> 4;
        const int rt = unit >> 3, h = unit & 7, row0 = rt * 128;
        if (h != hcache) { hcache = h;
            if (tid < 256) { const int d = tid >> 7, c = tid & 127, chg = d * 1024 + 128 * h + c;
                prm[(0 * 2 + d) * 128 + c] = P.in[I_LBA][chg]; prm[(1 * 2 + d) * 128 + c] = P.in[I_LBX][chg]; prm[(2 * 2 + d) * 128 + c] = log1pf(fexp_(-P.in[I_LLAM][chg])); } }
        int s0, s1; if (row0 < ML) { s0 = (row0 >> 14) << 14; s1 = s0 + SEQ; } else { s0 = ML + (((row0 - ML) >> 8) << 8); s1 = s0 + CTXL; }
        { const int c8 = tid & 15, tb = tid >> 4, ch0 = 128 * h + 8 * c8;
            f32x4 wq[4][2], bq[2]; bq[0] = *(const f32x4*)(P.in[I_LCB] + ch0); bq[1] = *(const f32x4*)(P.in[I_LCB] + ch0 + 4);
#pragma unroll
            for (int k = 0; k < 4; ++k) { const float zs = LIN8 ? 1.0f / (float)(1 << (FFN_SA1 + FFN_SB1)) : 1.0f;
                wq[k][0] = *(const f32x4*)(P.in[I_LCW] + k * 1024 + ch0) * zs; wq[k][1] = *(const f32x4*)(P.in[I_LCW] + k * 1024 + ch0 + 4) * zs; }
            u32x4 xv[4][4];
#pragma unroll
            for (int i = 0; i < 4; ++i)
#pragma unroll
                for (int k = 0; k < 4; ++k) { int r = row0 + tb + 32 * i + k - 2; r = r < s0 ? s0 : (r > s1 - 1 ? s1 - 1 : r); xv[i][k] = *(const u32x4*)(GXB + (size_t)r * 2048 + 1024 + ch0); }
            asm volatile("" ::: "memory");
#pragma unroll
            for (int i = 0; i < 4; ++i) { const int t = tb + 32 * i;
                float a[8] = {bq[0][0], bq[0][1], bq[0][2], bq[0][3], bq[1][0], bq[1][1], bq[1][2], bq[1][3]};
#pragma unroll
                for (int k = 0; k < 4; ++k) { const int r = row0 + t + k - 2; const float vm = (r >= s0 && r < s1) ? 1.0f : 0.0f; const u32x4 x = xv[i][k];
                    a[0] += vm * wq[k][0][0] * bflo(x.x); a[1] += vm * wq[k][0][1] * bfhi(x.x); a[2] += vm * wq[k][0][2] * bflo(x.y); a[3] += vm * wq[k][0][3] * bfhi(x.y);
                    a[4] += vm * wq[k][1][0] * bflo(x.z); a[5] += vm * wq[k][1][1] * bfhi(x.z); a[6] += vm * wq[k][1][2] * bflo(x.w); a[7] += vm * wq[k][1][3] * bfhi(x.w); }
                u32x4 o; o.x = pk2(a[0], a[1]); o.y = pk2(a[2], a[3]); o.z = pk2(a[4], a[5]); o.w = pk2(a[6], a[7]);
                *(LAS u32x4*)(ldsX + t * 272 + c8 * 16) = o; }
        }
        __syncthreads();
        f32x4 acc[8][4];
#pragma unroll
        for (int m = 0; m < 8; ++m)
#pragma unroll
            for (int n = 0; n < 4; ++n) acc[m][n] = (f32x4){0.f, 0.f, 0.f, 0.f};
        bf16x8 b[4], bn[4];
#pragma unroll
        for (int n = 0; n < 4; ++n) b[n] = *(const bf16x8*)(LW + ((size_t)(h * 512 + 64 * w + 16 * n + fr)) * 128 + 8 * fq);
#pragma unroll
        for (int ks = 0; ks < 4; ++ks) {
            if (ks < 3) {
#pragma unroll
                for (int n = 0; n < 4; ++n) bn[n] = *(const bf16x8*)(LW + ((size_t)(h * 512 + 64 * w + 16 * n + fr)) * 128 + 32 * (ks + 1) + 8 * fq); }
#pragma unroll
            for (int m = 0; m < 8; ++m) { const bf16x8 a = *(const LAS bf16x8*)(ldsX + (16 * m + fr) * 272 + ks * 64 + fq * 16);
#pragma unroll
                for (int n = 0; n < 4; ++n) acc[m][n] = __builtin_amdgcn_mfma_f32_16x16x32_bf16(b[n], a, acc[m][n], 0, 0, 0); }
            __builtin_amdgcn_sched_barrier(0);
#pragma unroll
            for (int n = 0; n < 4; ++n) b[n] = bn[n];
        }
#pragma unroll
        for (int m = 0; m < 8; ++m)
#pragma unroll
            for (int n = 0; n < 4; ++n) asm volatile("" : "+v"(acc[m][n]));
        asm volatile("" ::: "memory");
        const int ch = 128 * h + 16 * w + 4 * fq;
        f32x4 ba[2], bx[2], sp[2];
#pragma unroll
        for (int d = 0; d < 2; ++d) { const int co = d * 128 + 16 * w + 4 * fq; ba[d] = *(const LAS f32x4*)(prm + co); bx[d] = *(const LAS f32x4*)(prm + 256 + co); sp[d] = *(const LAS f32x4*)(prm + 512 + co); }
#pragma unroll
        for (int d = 0; d < 2; ++d) {
#pragma unroll
            for (int m = 0; m < 8; ++m) { const int t = 16 * m + fr; const size_t row = (size_t)(row0 + t);
                const u32x2 xw = *(const LAS u32x2*)(ldsX + t * 272 + (16 * w + 4 * fq) * 2); const float xc[4] = {bflo(xw.x), bfhi(xw.x), bflo(xw.y), bfhi(xw.y)};
                float la[4], bb[4];
#pragma unroll
                for (int r = 0; r < 4; ++r) { const float ra = sigmoidf_(acc[m][2 * d][r] + ba[d][r]), ii = sigmoidf_(acc[m][2 * d + 1][r] + bx[d][r]);
                    la[r] = -8.0f * ra * sp[d][r]; bb[r] = __builtin_amdgcn_sqrtf(fmaxf(1.0f - __builtin_amdgcn_exp2f(2.8853900817779268f * la[r]), 0.f)) * ii * xc[r]; }
                u32x2 ol, ob; ol.x = pk2(la[0], la[1]); ol.y = pk2(la[2], la[3]); *(u32x2*)(LA + ((size_t)d * MT + row) * 1024 + ch) = ol;
                ob.x = pk2(bb[0], bb[1]); ob.y = pk2(bb[2], bb[3]); *(u32x2*)(BB + ((size_t)d * MT + row) * 1024 + ch) = ob;
                u32x4 st; st.x = (ol.x & 0xffffu) | (ob.x << 16); st.y = (ol.x >> 16) | (ob.x & 0xffff0000u); st.z = (ol.y & 0xffffu) | (ob.y << 16); st.w = (ol.y >> 16) | (ob.y & 0xffff0000u);
                *(LAS u32x4*)(stg + t * 132 + 16 * w + 4 * fq) = st; }
            __syncthreads();
            { const int hf = tid >> 8, ck = (tid >> 7) & 1, cl = tid & 127; const LAS unsigned* sp_ = stg + (64 * ck) * 132 + cl;
                float s = 0.f, hh = 0.f;
#pragma unroll 8
                for (int i = 0; i < 32; ++i) { const int ii = 32 * hf + i; const unsigned v = sp_[(d ? 63 - ii : ii) * 132]; const float l = bflo(v); s += l; hh = fexp_(l) * hh + bfhi(v); }
                if (hf) hx[tid - 256] = (f32x2){s, hh};
                __syncthreads();
                if (!hf) { const f32x2 o = hx[tid]; *(f32x2*)(AGG + (((size_t)d * 520 + (size_t)(2 * rt + ck)) * 1024 + 128 * h + cl) * 2) = (f32x2){s + o[0], fexp_(o[0]) * hh + o[1]}; } }
        }
    }
}
__device__ __forceinline__ void lru_agg_phase(const Frame& F0) {
    Frame F = F0; F.tid = fresh_tid_w(F0.wave); F.lane = F.tid & 63;
    unsigned char* ws = F.ws; const bf16_t* LA = (const bf16_t*)(ws + WS_BIG + LRU_LA); const bf16_t* BB = (const bf16_t*)(ws + WS_BIG + LRU_BB); float* AGG = (float*)(ws + WS_AGG);
    for (int unit = F.vcu; unit < 520 * 2; unit += F.G) { const int cidx = unit >> 1, d = unit & 1; const size_t base = ((size_t)d * MT + (size_t)cidx * 64) * 1024 + 2 * F.tid;
        float s0 = 0.f, s1 = 0.f, h0 = 0.f, h1 = 0.f;
#pragma unroll 8
        for (int i = 0; i < 64; ++i) { const int t = d ? 63 - i : i; const unsigned lw = *(const unsigned*)(LA + base + (size_t)t * 1024), bw = *(const unsigned*)(BB + base + (size_t)t * 1024);
            const float l0 = bflo(lw), l1 = bfhi(lw); s0 += l0; s1 += l1; h0 = fexp_(l0) * h0 + bflo(bw); h1 = fexp_(l1) * h1 + bfhi(bw); }
        *(f32x4*)(AGG + (((size_t)d * 520 + cidx) * 1024 + 2 * F.tid) * 2) = (f32x4){s0, h0, s1, h1}; }
}
__device__ __forceinline__ void lru_carry_phase(const Frame& F0) {
    Frame F = F0; F.tid = fresh_tid_w(F0.wave); F.lane = F.tid & 63;
    unsigned char* ws = F.ws; const float* AGG = (const float*)(ws + WS_AGG); float* CARRY = (float*)(ws + WS_CARRY);
    LAS float* segS = (LAS float*)F.lds; LAS float* segH = segS + 512;
    for (int blk = F.vcu; blk < 128; blk += F.G) { const int cl = F.tid & 31, seg = F.tid >> 5, chain = blk * 32 + cl, b = chain >> 11, d = (chain >> 10) & 1, ch = chain & 1023;
        f32x2 ag[16], cx[4];
#pragma unroll
        for (int k = 0; k < 16; ++k) { const int i = seg * 16 + k, cidx = 256 * b + (d ? 255 - i : i); ag[k] = *(const f32x2*)(AGG + (((size_t)d * 520 + cidx) * 1024 + ch) * 2); }
#pragma unroll
        for (int i = 0; i < 4; ++i) { const int cidx = 512 + 4 * b + (d ? 3 - i : i); cx[i] = *(const f32x2*)(AGG + (((size_t)d * 520 + cidx) * 1024 + ch) * 2); }
        asm volatile("" ::: "memory");
        float S = 0.f, H = 0.f;
#pragma unroll
        for (int k = 0; k < 16; ++k) { S += ag[k][0]; H = fexp_(ag[k][0]) * H + ag[k][1]; }
        segS[seg * 32 + cl] = S; segH[seg * 32 + cl] = H;
        __syncthreads();
        float h = 0.f;
#pragma unroll
        for (int i = 0; i < 4; ++i) h = fexp_(cx[i][0]) * h + cx[i][1];
        for (int s2 = 0; s2 < seg; ++s2) h = fexp_(segS[s2 * 32 + cl]) * h + segH[s2 * 32 + cl];
#pragma unroll
        for (int k = 0; k < 16; ++k) { const int i = seg * 16 + k, cidx = 256 * b + (d ? 255 - i : i); CARRY[((size_t)d * 512 + cidx) * 1024 + ch] = h; h = fexp_(ag[k][0]) * h + ag[k][1]; }
        __syncthreads();
    }
}
#define SCAN_LD(dst_, base_, imm_) asm volatile("s_nop 4\n\tglobal_load_dword %0, %1, %2 offset:" #imm_ : "=v"(dst_) : "v"(voff), "s"(base_))
#define SCAN_LD32(arr_, base_, t0_) do { _Pragma("unroll") for (int t_ = 0; t_ < 32; t_ += 2) { const char* p_ = (base_) + (size_t)((t0_) + t_) * 2048; SCAN_LD(arr_[t_], p_, 0); SCAN_LD(arr_[t_ + 1], p_, 2048); } } while (0)
#define SCAN_LDG32(arr_, base_, t0_) do { _Pragma("unroll") for (int t_ = 0; t_ < 32; ++t_) { const char* p_ = (base_) + (size_t)((t0_) + t_) * 4096; SCAN_LD(arr_[t_], p_, 0); } } while (0)
#define SCAN_PIN32(arr_) do { _Pragma("unroll") for (int t_ = 0; t_ < 32; ++t_) asm volatile("" : "+v"(arr_[t_])); } while (0)
__device__ __forceinline__ void lru_scan_phase(const Frame& F0) {
    Frame F = F0; F.tid = fresh_tid_w(F0.wave); F.lane = F.tid & 63;
    unsigned char* ws = F.ws; const char* GXc = (const char*)(ws + WS_BIG); const char* LAc = (const char*)(ws + WS_BIG + LRU_LA); const char* BBc = (const char*)(ws + WS_BIG + LRU_BB);
    const float* CARRY = (const float*)(ws + WS_CARRY); bf16_t* S2 = (bf16_t*)(ws + WS_H);
    LAS f32x2* hfl = (LAS f32x2*)F.lds;
    const unsigned voff = 4u * (unsigned)F.tid; const size_t bo = (size_t)MT * 2048;
    for (int unit = F.vcu; unit < 512; unit += F.G) { const int cidx = unit; const size_t row0 = (size_t)cidx * 64; const int c2 = 2 * F.tid;
        const char* laF = LAc + row0 * 2048; const char* bbF = BBc + row0 * 2048; const char* laB = laF + bo; const char* bbB = bbF + bo; const char* gx = GXc + row0 * 4096;
        unsigned lw[32], bw[32], gw[32], bw2[32];
        SCAN_LD32(lw, laF, 0); SCAN_LD32(bw, bbF, 0); SCAN_LD32(gw, laF, 32); SCAN_LD32(bw2, bbF, 32);
        const f32x2 cf = *(const f32x2*)(CARRY + ((size_t)0 * 512 + cidx) * 1024 + c2), cb = *(const f32x2*)(CARRY + ((size_t)1 * 512 + cidx) * 1024 + c2);
        asm volatile("s_waitcnt vmcnt(0)" ::: "memory"); SCAN_PIN32(lw); SCAN_PIN32(bw); SCAN_PIN32(gw); SCAN_PIN32(bw2);
        float h0 = cf[0], h1 = cf[1];
#pragma unroll
        for (int t = 0; t < 32; ++t) { h0 = fexp_(bflo(lw[t])) * h0 + bflo(bw[t]); h1 = fexp_(bfhi(lw[t])) * h1 + bfhi(bw[t]); hfl[t * 512 + F.tid] = (f32x2){h0, h1}; }
        f32x2 hf2[32];
#pragma unroll
        for (int t = 0; t < 32; ++t) { h0 = fexp_(bflo(gw[t])) * h0 + bflo(bw2[t]); h1 = fexp_(bfhi(gw[t])) * h1 + bfhi(bw2[t]); hf2[t] = (f32x2){h0, h1}; }
        SCAN_LD32(lw, laB, 32); SCAN_LD32(bw, bbB, 32); SCAN_LDG32(gw, gx, 32);
        asm volatile("s_waitcnt vmcnt(0)" ::: "memory"); SCAN_PIN32(lw); SCAN_PIN32(bw); SCAN_PIN32(gw);
        float g0 = cb[0], g1 = cb[1];
#pragma unroll
        for (int t = 31; t >= 0; --t) { const size_t r = row0 + 32 + t;
            g0 = fexp_(bflo(lw[t])) * g0 + bflo(bw[t]); g1 = fexp_(bfhi(lw[t])) * g1 + bfhi(bw[t]);
            *(unsigned*)(S2 + r * 1024 + c2) = pk2(bflo(gw[t]) * (hf2[t][0] + g0), bfhi(gw[t]) * (hf2[t][1] + g1)); }
        SCAN_LD32(lw, laB, 0); SCAN_LD32(bw, bbB, 0); SCAN_LDG32(gw, gx, 0);
        asm volatile("s_waitcnt vmcnt(0)" ::: "memory"); SCAN_PIN32(lw); SCAN_PIN32(bw); SCAN_PIN32(gw);
#pragma unroll
        for (int t = 31; t >= 0; --t) { const size_t r = row0 + t;
            g0 = fexp_(bflo(lw[t])) * g0 + bflo(bw[t]); g1 = fexp_(bfhi(lw[t])) * g1 + bfhi(bw[t]);
            const f32x2 hf = hfl[t * 512 + F.tid];
            *(unsigned*)(S2 + r * 1024 + c2) = pk2(bflo(gw[t]) * (hf[0] + g0), bfhi(gw[t]) * (hf[1] + g1)); }
    }
}

__device__ __forceinline__ void moe_index_phase(const Frame& F0) {
    Frame F = F0; F.tid = fresh_tid_w(F0.wave); F.lane = F.tid & 63;
    unsigned char* ws = F.ws; const int tid = F.tid, lane = F.lane;
    int* counts = (int*)(ws + WS_COUNTS); int* tile_exp = counts + 4096; int* ntiles_p = counts + 5120; unsigned* route = (unsigned*)(ws + WS_ROUTE);
    const unsigned char* H8 = ws + WS_H; unsigned char* AS8 = ws + WS_BIG;
    LAS int* lc = (LAS int*)F.lds;
    LAS int* tot = lc + 2048; LAS int* pre = tot + 8; LAS int* seg = pre + 8; LAS unsigned* e01 = (LAS unsigned*)(seg + 16); LAS int* pos = (LAS int*)(e01 + 128);
    for (int blk = F.vcu; blk < 256; blk += F.G) {
        u32x4 o[16];
#pragma unroll
        for (int i = 0; i < 16; ++i) { const size_t m = (size_t)blk * 128 + F.wave * 16 + i; o[i] = *(const u32x4*)(H8 + m * 1024 + 16 * lane); }
        { const int e = F.wave; int t = 0, pz = 0;
#pragma unroll
            for (int jj = 0; jj < 4; ++jj) { const int b = 4 * lane + jj; const int c = counts[b * 8 + e]; t += c; pz += (b < blk) ? c : 0; }
#pragma unroll
            for (int o = 1; o < 64; o <<= 1) { t += __shfl_xor(t, o); pz += __shfl_xor(pz, o); }
            if (lane == 0) { tot[e] = t; pre[e] = pz; } }
        __syncthreads();
        if (tid == 0) { int s = 0; for (int e = 0; e < 8; ++e) { seg[e] = s; s += ((tot[e] + 255) >> 8) << 8; } seg[8] = s;
            if (blk == 0) { *ntiles_p = s >> 8; for (int e = 0; e < 8; ++e) for (int pm = seg[e] >> 8; pm < (seg[e + 1] >> 8); ++pm) tile_exp[pm] = e; } }
        __syncthreads();
        { const int e = F.wave; int base = seg[e] + pre[e];
#pragma unroll
            for (int ps = 0; ps < 2; ++ps) { const int i = lane + 64 * ps; const unsigned wv = route[(size_t)(blk * 128 + i) * 8]; const bool m0 = (int)(wv & 255u) == e, m1 = (int)((wv >> 8) & 255u) == e;
                const unsigned long long bal = __ballot(m0 || m1); const int rank = (int)__builtin_amdgcn_mbcnt_hi((unsigned)(bal >> 32), __builtin_amdgcn_mbcnt_lo((unsigned)bal, 0u));
                if (m0) pos[2 * i] = base + rank; if (m1) pos[2 * i + 1] = base + rank;
                base += __builtin_popcountll(bal); } }
        __syncthreads();
        if (tid < 128) { route[(size_t)(blk * 128 + tid) * 8 + 3] = (unsigned)pos[2 * tid]; route[(size_t)(blk * 128 + tid) * 8 + 4] = (unsigned)pos[2 * tid + 1]; }
        {
#pragma unroll
            for (int i = 0; i < 16; ++i) { const int tl = F.wave * 16 + i; const int p0 = pos[2 * tl], p1 = pos[2 * tl + 1];
                *(u32x4*)(AS8 + (size_t)p0 * 1024 + 16 * lane) = o[i]; *(u32x4*)(AS8 + (size_t)p1 * 1024 + 16 * lane) = o[i]; } }
        __syncthreads();
    }
}
constexpr size_t HY_YP = 0, HY_KS = 64 * MiB, HY_Y1 = 128 * MiB, HY_XP = 192 * MiB;
__device__ __forceinline__ int seg_lds(int chl, int n0) { return (chl * 32 + n0) * 17 + ((chl >> 3) << 3); }

__device__ __forceinline__ void hy_pack_phase(const Frame& F0) {
    Frame F = F0; F.tid = fresh_tid_w(F0.wave); F.lane = F.tid & 63;
    const Params& P = *F.P; unsigned char* ws = F.ws; const int tid = F.tid;
    const bf16_t* Z = (const bf16_t*)(ws + WS_BIG); unsigned* XP = (unsigned*)(ws + WS_BIG + HY_XP);
    LAS unsigned char* L8 = F.lds; LAS unsigned* L32 = (LAS unsigned*)F.lds;
    for (int unit = F.vcu; unit < 3 * 16 * 32; unit += F.G) {
        const int n1 = unit & 31, cb = (unit >> 5) & 15, part = unit >> 9; const int chbase = part * 1024 + cb * 64;
        { const int c8 = tid & 7, n0 = (tid >> 3) & 31, r0 = tid >> 8, ch0 = chbase + 8 * c8;
            f32x4 wq[3][2], bq[2]; bq[0] = *(const f32x4*)(P.in[I_HCB] + ch0); bq[1] = *(const f32x4*)(P.in[I_HCB] + ch0 + 4);
#pragma unroll
            for (int k = 0; k < 3; ++k) { const float zs = HIN8 ? 1.0f / (float)(1 << (FFN_SA1 + FFN_SB1)) : 1.0f;
                wq[k][0] = *(const f32x4*)(P.in[I_HCW] + k * 3072 + ch0) * zs; wq[k][1] = *(const f32x4*)(P.in[I_HCW] + k * 3072 + ch0 + 4) * zs; }
#pragma unroll 1
            for (int g = 0; g < 4; ++g) {
                u32x4 xv[4][3];
#pragma unroll
                for (int j = 0; j < 4; ++j) { const int rest = r0 + 2 * (4 * g + j), n2 = rest & 15, b = rest >> 4, t = n0 + 32 * n1 + 1024 * n2;
#pragma unroll
                    for (int k = 0; k < 3; ++k) { int tt = t + k - 1; tt = tt < 0 ? 0 : (tt > SEQ - 1 ? SEQ - 1 : tt); xv[j][k] = *(const u32x4*)(Z + ((size_t)b * SEQ + tt) * 3072 + ch0); } }
                asm volatile("" ::: "memory");
#pragma unroll
                for (int j = 0; j < 4; ++j) { const int rest = r0 + 2 * (4 * g + j), n2 = rest & 15, b = rest >> 4, t = n0 + 32 * n1 + 1024 * n2;
                    float a[8] = {bq[0][0], bq[0][1], bq[0][2], bq[0][3], bq[1][0], bq[1][1], bq[1][2], bq[1][3]};
#pragma unroll
                    for (int k = 0; k < 3; ++k) { const int tt = t + k - 1; const float vm = (tt >= 0 && tt < SEQ) ? 1.0f : 0.0f; const u32x4 x = xv[j][k];
                        a[0] += vm * wq[k][0][0] * bflo(x.x); a[1] += vm * wq[k][0][1] * bfhi(x.x); a[2] += vm * wq[k][0][2] * bflo(x.y); a[3] += vm * wq[k][0][3] * bfhi(x.y);
                        a[4] += vm * wq[k][1][0] * bflo(x.z); a[5] += vm * wq[k][1][1] * bfhi(x.z); a[6] += vm * wq[k][1][2] * bflo(x.w); a[7] += vm * wq[k][1][3] * bfhi(x.w); }
#pragma unroll
                    for (int k = 0; k < 8; ++k) *(LAS bf16_t*)(L8 + (seg_lds(8 * c8 + k, n0) + n2) * 4 + 2 * b) = (bf16_t)f2bf(a[k]); }
            }
        }
        __syncthreads();
#pragma unroll 4
        for (int i = 0; i < 16; ++i) { const int idx = tid + 512 * i, qd = idx & 3, seg = idx >> 2, chl = seg >> 5, n0 = seg & 31; const int so = seg_lds(chl, n0) + 4 * qd;
            u32x4 o; o.x = L32[so]; o.y = L32[so + 1]; o.z = L32[so + 2]; o.w = L32[so + 3];
            *(u32x4*)(XP + ((size_t)(chbase + chl) * SEQ + (size_t)(n0 * 32 + n1) * 16 + 4 * qd)) = o; }
        __syncthreads();
    }
}
__device__ __forceinline__ void hy_unpack_phase(const Frame& F0) {
    Frame F = F0; F.tid = fresh_tid_w(F0.wave); F.lane = F.tid & 63;
    unsigned char* ws = F.ws; const int tid = F.tid;
    const unsigned* YP = (const unsigned*)(ws + WS_BIG + HY_YP); bf16_t* YT = (bf16_t*)(ws + WS_H);
    LAS unsigned char* L8 = F.lds; LAS unsigned* L32 = (LAS unsigned*)F.lds;
    for (int unit = F.vcu; unit < 16 * 32; unit += F.G) {
        const int n1 = unit & 31, cb = unit >> 5; const int chbase = cb * 64;
        { u32x4 v[16];
#pragma unroll
            for (int i = 0; i < 16; ++i) { const int idx = tid + 512 * i, qd = idx & 3, seg = idx >> 2, chl = seg >> 5, n0 = seg & 31;
                v[i] = *(const u32x4*)(YP + ((size_t)(chbase + chl) * SEQ + (size_t)(n0 * 32 + n1) * 16 + 4 * qd)); }
            asm volatile("" ::: "memory");
#pragma unroll
            for (int i = 0; i < 16; ++i) { const int idx = tid + 512 * i, qd = idx & 3, seg = idx >> 2, chl = seg >> 5, n0 = seg & 31; const int so = seg_lds(chl, n0) + 4 * qd;
                L32[so] = v[i].x; L32[so + 1] = v[i].y; L32[so + 2] = v[i].z; L32[so + 3] = v[i].w; } }
        __syncthreads();
#pragma unroll 4
        for (int i = 0; i < 16; ++i) { const int idx = tid + 512 * i, c8 = idx & 7, n0 = (idx >> 3) & 31, rest = idx >> 8, n2 = rest & 15, b = rest >> 4;
            const int t = n0 + 32 * n1 + 1024 * n2; const size_t row = (size_t)b * SEQ + t;
            unsigned hv[8];
#pragma unroll
            for (int k = 0; k < 8; ++k) hv[k] = *(const LAS bf16_t*)(L8 + (seg_lds(8 * c8 + k, n0) + n2) * 4 + 2 * b);
            u32x4 o; o.x = hv[0] | (hv[1] << 16); o.y = hv[2] | (hv[3] << 16); o.z = hv[4] | (hv[5] << 16); o.w = hv[6] | (hv[7] << 16);
            *(u32x4*)(YT + row * 1024 + chbase + 8 * c8) = o; }
        __syncthreads();
    }
}

__device__ __forceinline__ int xaddr(int x, int y, int z) { return x * 1152 + y * 36 + z; }

struct FftCtx {
    bf16x8 afr[2][4];
    bf16x8 invmask;
    const LAS float* twl;
};
__device__ __forceinline__ void fft_ctx_init(FftCtx& C, int lane, int wave, LAS float* twl) {
    const int i = lane & 31, h = lane >> 5, pp = i & 1;
#pragma unroll
    for (int rb = 0; rb < 2; ++rb)
#pragma unroll
        for (int s = 0; s < 4; ++s) { const int zp = 16 * rb + (i >> 1);
#pragma unroll
            for (int e = 0; e < 8; ++e) { const int z = 8 * s + 4 * h + (e >> 1), p = e & 1; const float th = -6.283185307179586f * (float)((z * zp) & 31) * (1.0f / 32.0f);
                const float fr = __cosf(th), fi = __sinf(th); const float v = (pp == p) ? fr : (pp == 0 ? -fi : fi);
                C.afr[rb][s][e] = (short)f2bf(v); } }
#pragma unroll
    for (int e = 0; e < 8; ++e) C.invmask[e] = (short)(((e & 1) != pp) ? 0x8000 : 0);
#pragma unroll
    for (int rb = 0; rb < 2; ++rb)
#pragma unroll
        for (int g = 0; g < 4; ++g)
#pragma unroll
            for (int e = 0; e < 2; ++e) { const int zp = 16 * rb + 4 * g + 2 * h + e; const float th = -6.283185307179586f * (float)((i * zp) & 1023) * (1.0f / 1024.0f);
                if (wave == 0) *(LAS f32x2*)(twl + lane * 36 + 2 * (rb * 8 + g * 2 + e)) = (f32x2){__cosf(th), __sinf(th)}; }
    C.twl = twl + lane * 36;
}
template <int NS>
__device__ __forceinline__ void fft_read(const LAS unsigned* X, int x, int lane, bf16x8 (&b)[4]) {
    const int j = lane & 31, h = lane >> 5;
#pragma unroll
    for (int s = 0; s < NS; ++s) b[s] = *(const LAS bf16x8*)(X + x * 1152 + j * 36 + 4 * (2 * s + h));
}
template <int NS, int NRB, bool INV>
__device__ __forceinline__ void fft_mma(const FftCtx& C, const bf16x8 (&b)[4], f32x16 (&acc)[2]) {
#pragma unroll
    for (int rb = 0; rb < NRB; ++rb) {
#pragma unroll
        for (int r = 0; r < 16; ++r) acc[rb][r] = 0.f;
#pragma unroll
        for (int s = 0; s < NS; ++s) { const bf16x8 a = INV ? (bf16x8)(C.afr[rb][s] ^ C.invmask) : C.afr[rb][s]; acc[rb] = __builtin_amdgcn_mfma_f32_32x32x16_bf16(a, b[s], acc[rb], 0, 0, 0); } }
}
template <int NRB, bool INV, int TW>
__device__ __forceinline__ void fft_twiddle(const FftCtx& C, f32x16 (&acc)[2], int x, int lane) {
    if (TW == 0) return;
    float ur = 1.f, ui = 0.f;
    if (TW == 2) { const int j = lane & 31; const float th = -6.283185307179586f * (float)(j * x) * (1.0f / 32768.0f); ur = __cosf(th); ui = __sinf(th); }
#pragma unroll
    for (int rb = 0; rb < NRB; ++rb)
#pragma unroll
        for (int g = 0; g < 4; ++g)
#pragma unroll
            for (int e = 0; e < 2; ++e) { const f32x2 twv = *(const LAS f32x2*)(C.twl + 2 * (rb * 8 + g * 2 + e)); float wr = twv[0], wi = twv[1];
                if (TW == 2) { const float a = wr * ur - wi * ui, b = wr * ui + wi * ur; wr = a; wi = b; }
                if (INV) wi = -wi;
                const float re = acc[rb][4 * g + 2 * e], im = acc[rb][4 * g + 2 * e + 1];
                acc[rb][4 * g + 2 * e] = re * wr - im * wi; acc[rb][4 * g + 2 * e + 1] = re * wi + im * wr; }
}
template <int NRB, int MODE>
__device__ __forceinline__ void fft_write(LAS unsigned* X, const f32x16 (&acc)[2], int x, int lane) {
    const int j = lane & 31, h = lane >> 5;
    int base = (MODE == 0) ? xaddr(2 * h, x, j) : (MODE == 1) ? xaddr(x, 2 * h, j) : xaddr(x, j, 2 * h);
    asm volatile("" : "+v"(base));
    LAS unsigned* Xb = X + base;
#pragma unroll
    for (int rb = 0; rb < NRB; ++rb)
#pragma unroll
        for (int g = 0; g < 4; ++g) { const int zc = 16 * rb + 4 * g;
            const unsigned v0 = pk2(acc[rb][4 * g], acc[rb][4 * g + 1]), v1 = pk2(acc[rb][4 * g + 2], acc[rb][4 * g + 3]);
            if (MODE == 0) { Xb[zc * 1152] = v0; Xb[(zc + 1) * 1152] = v1; }
            else if (MODE == 1) { Xb[zc * 36] = v0; Xb[(zc + 1) * 36] = v1; }
            else { *(LAS u32x2*)(Xb + zc) = (u32x2){v0, v1}; } }
}
template <int NS, int NRB, bool INV, int TW, int MODE>
__device__ __forceinline__ void fft_stage_local(const FftCtx& C, LAS unsigned* X, int wave, int lane) {
#pragma unroll 1
    for (int i = 0; i < 4; ++i) { const int x = 4 * wave + i; bf16x8 b[4]; f32x16 acc[2];
        fft_read<NS>(X, x, lane, b); fft_mma<NS, NRB, INV>(C, b, acc); fft_twiddle<NRB, INV, TW>(C, acc, x, lane); fft_write<NRB, MODE>(X, acc, x, lane); }
}
template <int NS, bool INV>
__device__ __forceinline__ void fft_stage_global(const FftCtx& C, LAS unsigned* X, int wave, int lane) {
    bf16x8 b[4][4];
#pragma unroll
    for (int i = 0; i < 4; ++i) fft_read<NS>(X, 4 * wave + i, lane, b[i]);
    LDS_WAIT(); __syncthreads();
#pragma unroll
    for (int i = 0; i < 4; ++i) { const int x = 4 * wave + i; f32x16 acc[2];
        fft_mma<NS, 2, INV>(C, b[i], acc); fft_twiddle<2, INV, 1>(C, acc, x, lane); fft_write<2, 0>(X, acc, x, lane); __builtin_amdgcn_sched_barrier(0); }
    LDS_WAIT(); __syncthreads();
}

__device__ __forceinline__ void hy_fft_phase(const Frame& F0) {
    Frame F = F0; F.tid = fresh_tid_w(F0.wave); F.lane = F.tid & 63;
    const Params& P = *F.P; unsigned char* ws = F.ws; const int tid = F.tid, lane = F.lane, wave = F.wave, j = lane & 31, h = lane >> 5;
    LAS unsigned* X = (LAS unsigned*)F.lds;
    const bf16_t* KP = (const bf16_t*)(ws + WS_Y); const unsigned* XP = (const unsigned*)(ws + WS_BIG + HY_XP); unsigned* YP = (unsigned*)(ws + WS_BIG + HY_YP);
    u32x2* KS = (u32x2*)(ws + WS_BIG + HY_KS) + (size_t)blockIdx.x * 32768; u32x2* Y1 = (u32x2*)(ws + WS_BIG + HY_Y1) + (size_t)blockIdx.x * 8192;
    FftCtx C; fft_ctx_init(C, lane, wave, (LAS float*)(F.lds + 147712)); __syncthreads();
    for (int ch = F.vcu; ch < 1024; ch += F.G) {
#ifdef FFT_REP_FILT
        for (int rep_ = 0; rep_ < 2; ++rep_)
#endif
        {
            const bf16_t* kpa = KP + (size_t)ch * 32768; const bf16_t* kpb = KP + (size_t)(1024 + ch) * 32768;
            u32x4 fa[4][2], fb[4][2];
#pragma unroll
            for (int i = 0; i < 4; ++i) { const int x = 4 * wave + i; const size_t eo = (size_t)(x * 32 + j) * 32 + 16 * h;
                fa[i][0] = *(const u32x4*)(kpa + eo); fa[i][1] = *(const u32x4*)(kpa + eo + 8); fb[i][0] = *(const u32x4*)(kpb + eo); fb[i][1] = *(const u32x4*)(kpb + eo + 8); }
            asm volatile("" ::: "memory");
#pragma unroll
            for (int i = 0; i < 4; ++i) { const int x = 4 * wave + i;
                const unsigned wa[8] = {fa[i][0].x, fa[i][0].y, fa[i][0].z, fa[i][0].w, fa[i][1].x, fa[i][1].y, fa[i][1].z, fa[i][1].w};
                const unsigned wb[8] = {fb[i][0].x, fb[i][0].y, fb[i][0].z, fb[i][0].w, fb[i][1].x, fb[i][1].y, fb[i][1].z, fb[i][1].w};
#pragma unroll
                for (int c = 0; c < 4; ++c) { u32x4 o4; o4.x = (wa[2 * c] & 0xffffu) | (wb[2 * c] << 16); o4.y = (wa[2 * c] >> 16) | (wb[2 * c] & 0xffff0000u);
                    o4.z = (wa[2 * c + 1] & 0xffffu) | (wb[2 * c + 1] << 16); o4.w = (wa[2 * c + 1] >> 16) | (wb[2 * c + 1] & 0xffff0000u);
                    *(LAS u32x4*)(X + xaddr(x, j, 16 * h + 4 * c)) = o4; } }
            fft_stage_global<4, false>(C, X, wave, lane);
            fft_stage_local<4, 2, false, 2, 1>(C, X, wave, lane);
#pragma unroll 1
            for (int i = 0; i < 4; ++i) { const int x = 4 * wave + i; bf16x8 b[4]; f32x16 acc[2]; fft_read<4>(X, x, lane, b); fft_mma<4, 2, false>(C, b, acc); fft_write<2, 2>(X, acc, x, lane); }
            LDS_WAIT(); __syncthreads();
#pragma unroll 1
            for (int i = 0; i < 4; ++i) { const int x = 4 * wave + i, xq = (32 - x) & 31, c1 = (x != 0) ? 1 : 0, jq = (-j - c1) & 31, b2 = (x != 0 || j != 0) ? 1 : 0;
                const LAS unsigned* own = X + xaddr(x, j, 2 * h); const LAS unsigned* pb = X + xaddr(xq, jq, 0); const float hs = 0.5f / 32768.0f;
#pragma unroll
                for (int rb = 0; rb < 2; ++rb)
#pragma unroll
                    for (int g = 0; g < 4; ++g) { const u32x2 ow = *(const LAS u32x2*)(own + 16 * rb + 4 * g); unsigned k0w[2], k1w[2];
#pragma unroll
                        for (int e = 0; e < 2; ++e) { const int zz = 16 * rb + 4 * g + 2 * h + e, zq = (-zz - b2) & 31; const unsigned pw = pb[zq], zw = e ? ow.y : ow.x;
                            const float zr = bflo(zw), zi = bfhi(zw), pr = bflo(pw), pi = bfhi(pw);
                            k0w[e] = pk2(hs * (zr + pr), hs * (zi - pi)); k1w[e] = pk2(hs * (zi + pi), hs * (pr - zr)); }
                        KS[(size_t)((0 * 4 + i) * 8 + rb * 4 + g) * 512 + tid] = (u32x2){k0w[0], k0w[1]}; KS[(size_t)((1 * 4 + i) * 8 + rb * 4 + g) * 512 + tid] = (u32x2){k1w[0], k1w[1]}; } }
            LDS_WAIT(); __syncthreads();
        }
        const unsigned* vp = XP + (size_t)(2 * 1024 + ch) * SEQ;
        { u32x4 sv[4][2];
#pragma unroll
            for (int i = 0; i < 4; ++i) { const int x = 4 * wave + i; sv[i][0] = *(const u32x4*)(vp + (x * 32 + j) * 16 + 8 * h); sv[i][1] = *(const u32x4*)(vp + (x * 32 + j) * 16 + 8 * h + 4); }
            asm volatile("" ::: "memory");
#pragma unroll
            for (int i = 0; i < 4; ++i) { const int x = 4 * wave + i; *(LAS u32x4*)(X + xaddr(x, j, 8 * h)) = sv[i][0]; *(LAS u32x4*)(X + xaddr(x, j, 8 * h + 4)) = sv[i][1]; } }
#pragma unroll 1
        for (int o = 0; o < 2; ++o) {
            const float bias = P.in[I_HBIAS][o * 1024 + ch];
            const unsigned* gp = XP + (size_t)(o * 1024 + ch) * SEQ;
            fft_stage_global<2, false>(C, X, wave, lane);
            fft_stage_local<4, 2, false, 2, 1>(C, X, wave, lane);
            u32x2 kq[8];
#pragma unroll
            for (int q = 0; q < 8; ++q) kq[q] = KS[(size_t)((o * 4) * 8 + q) * 512 + tid];
#pragma unroll 1
            for (int i = 0; i < 4; ++i) { const int x = 4 * wave + i; bf16x8 b[4]; f32x16 acc[2]; u32x2 kc[8];
#pragma unroll
                for (int q = 0; q < 8; ++q) kc[q] = kq[q];
                if (i < 3) {
#pragma unroll
                    for (int q = 0; q < 8; ++q) kq[q] = KS[(size_t)((o * 4 + i + 1) * 8 + q) * 512 + tid]; }
                asm volatile("" ::: "memory");
                fft_read<4>(X, x, lane, b); fft_mma<4, 2, false>(C, b, acc);
#pragma unroll
                for (int rb = 0; rb < 2; ++rb)
#pragma unroll
                    for (int g = 0; g < 4; ++g) { const u32x2 kw = kc[rb * 4 + g];
                        { const float kr = bflo(kw.x), ki = bfhi(kw.x), re = acc[rb][4 * g], im = acc[rb][4 * g + 1]; acc[rb][4 * g] = re * kr - im * ki; acc[rb][4 * g + 1] = re * ki + im * kr; }
                        { const float kr = bflo(kw.y), ki = bfhi(kw.y), re = acc[rb][4 * g + 2], im = acc[rb][4 * g + 3]; acc[rb][4 * g + 2] = re * kr - im * ki; acc[rb][4 * g + 3] = re * ki + im * kr; } }
                fft_write<2, 2>(X, acc, x, lane); }
            fft_stage_global<4, true>(C, X, wave, lane);
            fft_stage_local<4, 2, true, 2, 1>(C, X, wave, lane);
            u32x2 gq[4], uq[4];
#define HY_GU_ISSUE(i_) do { const size_t eo_ = (size_t)((4 * wave + (i_)) * 32 + j) * 16 + 2 * h; _Pragma("unroll") for (int g_ = 0; g_ < 4; ++g_) { gq[g_] = *(const u32x2*)(gp + eo_ + 4 * g_); \
                if (o == 0) uq[g_] = *(const u32x2*)(vp + eo_ + 4 * g_); else uq[g_] = Y1[(size_t)((i_) * 4 + g_) * 512 + tid]; } } while (0)
            HY_GU_ISSUE(0);
#pragma unroll 1
            for (int i = 0; i < 4; ++i) { const int x = 4 * wave + i; bf16x8 b[4]; f32x16 acc[2]; u32x2 gc[4], uc[4];
#pragma unroll
                for (int g = 0; g < 4; ++g) { gc[g] = gq[g]; uc[g] = uq[g]; }
                if (i < 3) HY_GU_ISSUE(i + 1);
                asm volatile("" ::: "memory");
                fft_read<4>(X, x, lane, b); fft_mma<4, 1, true>(C, b, acc);
                const size_t eo = (size_t)(x * 32 + j) * 16 + 2 * h;
#pragma unroll
                for (int g = 0; g < 4; ++g) { const u32x2 gt = gc[g];
                    const u32x2 uu = uc[g];
                    const float y00 = bflo(gt.x) * (acc[0][4 * g] + bias * bflo(uu.x)), y01 = bfhi(gt.x) * (acc[0][4 * g + 1] + bias * bfhi(uu.x));
                    const float y10 = bflo(gt.y) * (acc[0][4 * g + 2] + bias * bflo(uu.y)), y11 = bfhi(gt.y) * (acc[0][4 * g + 3] + bias * bfhi(uu.y));
                    const u32x2 ov = (u32x2){pk2(y00, y01), pk2(y10, y11)};
                    if (o == 0) { Y1[(size_t)(i * 4 + g) * 512 + tid] = ov; *(LAS u32x2*)(X + xaddr(x, j, 4 * g + 2 * h)) = ov; }
                    else *(u32x2*)(YP + (size_t)ch * SEQ + eo + 4 * g) = ov; } }
        }
    }
}
__device__ __forceinline__ void pool_phase(const Frame& F0) {
    Frame F = F0; F.tid = fresh_tid_w(F0.wave); F.lane = F.tid & 63;
    const Params& P = *F.P; unsigned char* ws = F.ws; const int tid = F.tid, lane = F.lane, w = F.wave, fr = lane & 15, fq = lane >> 4;
    const bf16_t* PB = (const bf16_t*)(ws + WS_BIG); bf16_t* A2 = (bf16_t*)(ws + WS_BIG + 64 * MiB); const bf16_t* PW = (const bf16_t*)(ws + WS_POOLW);
    LAS unsigned char* ldsP = F.lds;
    LAS unsigned char* ldsQ = F.lds + 76032;
    for (int unit = F.vcu; unit < (ML / 128) * 4; unit += F.G) {
        const int tile = unit >> 2, g = unit & 3, row0 = tile * 128, s0 = (row0 >> 14) << 14, t0 = row0 - s0, half = 1 << g;
        bf16x8 bw[8][2]; f32x4 bgq[2], scq[2];
        { u32x4 v[9];
#pragma unroll
            for (int i = 0; i < 9; ++i) { const int idx = tid + 512 * i, rr = idx >> 5, c8 = idx & 31; int t = t0 - 8 + rr; t = t < 0 ? 0 : (t > SEQ - 1 ? SEQ - 1 : t);
                v[i] = *(const u32x4*)(PB + (size_t)(s0 + t) * 1024 + 256 * g + 8 * c8); }
#pragma unroll
            for (int ks = 0; ks < 8; ++ks)
#pragma unroll
                for (int n = 0; n < 2; ++n) bw[ks][n] = *(const bf16x8*)(PW + ((size_t)(g * 256 + 32 * w + 16 * n + fr)) * 256 + 32 * ks + 8 * fq);
#pragma unroll
            for (int n = 0; n < 2; ++n) { const int d = 32 * w + 16 * n + 4 * fq; bgq[n] = *(const f32x4*)(P.in[I_PBG] + g * 256 + d); scq[n] = *(const f32x4*)(P.in[I_PSCALE] + g * 256 + d); }
            asm volatile("" ::: "memory");
#pragma unroll
            for (int i = 0; i < 9; ++i) { const int idx = tid + 512 * i, rr = idx >> 5, c8 = idx & 31; const int t = t0 - 8 + rr;
                u32x4 o = v[i]; if (t < 0 || t >= SEQ) o = (u32x4){0u, 0u, 0u, 0u};
                *(LAS u32x4*)(ldsP + rr * 528 + c8 * 16) = o; } }
        __syncthreads();
#pragma unroll 1
        for (int i = 0; i < 8; ++i) { const int idx = tid + 512 * i, tl = idx >> 5, c8 = idx & 31; const int t = t0 + tl;
            const int lo = (t - half) < 0 ? 0 : (t - half), hi = (t + half) > SEQ ? SEQ : (t + half); const float inv = 1.0f / (float)(hi - lo);
            float a[8];
#pragma unroll
            for (int k = 0; k < 8; ++k) a[k] = 0.f;
            for (int s = lo; s < hi; ++s) { const u32x4 v = *(const LAS u32x4*)(ldsP + (s - t0 + 8) * 528 + c8 * 16);
                a[0] += bflo(v.x); a[1] += bfhi(v.x); a[2] += bflo(v.y); a[3] += bfhi(v.y); a[4] += bflo(v.z); a[5] += bfhi(v.z); a[6] += bflo(v.w); a[7] += bfhi(v.w); }
            const u32x4 c = *(const LAS u32x4*)(ldsP + (tl + 8) * 528 + c8 * 16);
            const float zs = PIN8 ? 1.0f / (float)(1 << (FFN_SA1 + FFN_SB1)) : 1.0f, iz = inv * zs;
            u32x4 o; o.x = pk2(a[0] * iz - bflo(c.x) * zs, a[1] * iz - bfhi(c.x) * zs); o.y = pk2(a[2] * iz - bflo(c.y) * zs, a[3] * iz - bfhi(c.y) * zs);
            o.z = pk2(a[4] * iz - bflo(c.z) * zs, a[5] * iz - bfhi(c.z) * zs); o.w = pk2(a[6] * iz - bflo(c.w) * zs, a[7] * iz - bfhi(c.w) * zs);
            *(LAS u32x4*)(ldsQ + tl * 528 + c8 * 16) = o; }
        __syncthreads();
        f32x4 acc[8][2];
#pragma unroll
        for (int m = 0; m < 8; ++m) { acc[m][0] = (f32x4){0.f, 0.f, 0.f, 0.f}; acc[m][1] = acc[m][0]; }
#pragma unroll
        for (int ks = 0; ks < 8; ++ks) {
            const bf16x8 b[2] = {bw[ks][0], bw[ks][1]};
#pragma unroll
            for (int m = 0; m < 8; ++m) { const bf16x8 a = *(const LAS bf16x8*)(ldsQ + (16 * m + fr) * 528 + ks * 64 + fq * 16);
                acc[m][0] = __builtin_amdgcn_mfma_f32_16x16x32_bf16(b[0], a, acc[m][0], 0, 0, 0); acc[m][1] = __builtin_amdgcn_mfma_f32_16x16x32_bf16(b[1], a, acc[m][1], 0, 0, 0); }
        }
#pragma unroll
        for (int n = 0; n < 2; ++n) { const int d = 32 * w + 16 * n + 4 * fq; const f32x4 bg = bgq[n], sc = scq[n];
#pragma unroll
            for (int m = 0; m < 8; ++m) { const size_t row = (size_t)(row0 + 16 * m + fr);
                u32x2 o; o.x = pk2((acc[m][n][0] + bg[0]) * sc[0], (acc[m][n][1] + bg[1]) * sc[1]); o.y = pk2((acc[m][n][2] + bg[2]) * sc[2], (acc[m][n][3] + bg[3]) * sc[3]);
                *(u32x2*)(A2 + row * 1024 + 256 * g + d) = o; } }
        __syncthreads();
    }
}
constexpr int LDS_BYTES = 157696;
constexpr int LDS_CTL_OFF = 147456;
#ifndef SLQ
#define SLQ 1
#endif
#ifndef STOP_AFTER
#define STOP_AFTER 99
#endif
#ifndef REP_MASK
#define REP_MASK 0u
#endif
#define RUN(bit, ...) do { __VA_ARGS__; if ((REP_MASK >> (bit)) & 1u) { GRID_BAR(); __VA_ARGS__; } } while (0)

#define GEMM_ACT(Aptr, Bptr, nM_, nN_, K_, Optr, ldc_, gcols_) do { pg8::Sched S_; S_.init((Aptr), (Bptr), (nM_), (nN_), (K_), G, cid); pg8::EpiAct E_{(bf16_t*)(Optr), (ldc_), (gcols_)}; pg8::gemm_phase(F.lds, (K_), S_, E_, F.wave); } while (0)
#define GEMM_SWIGLU(Aptr, Bptr, nM_, nN_, K_, Optr, ldc_) do { pg8::Sched S_; S_.init((Aptr), (Bptr), (nM_), (nN_), (K_), G, cid); pg8::EpiSwiGLU E_{(bf16_t*)(Optr), (ldc_), 0}; pg8::gemm_phase(F.lds, (K_), S_, E_, F.wave); } while (0)

#define SLACK_CONV(s_) do { if (G == 256 && cid >= SL_FIRST[s_]) conv_slot(F, (s_), cid - SL_FIRST[s_]); } while (0)
#define FFN8_UP(l_, nM_) do { int k1_ = 1024; asm volatile("" : "+s"(k1_)); pg8::Sched S_; S_.init(ws + WS_H, ws + W_FGU + (size_t)(l_) * 11 * MiB, (nM_), 2 * DFF / 256, k1_, G, cid, 1); \
          pg8::EpiSwiGLU8 E_{ws + WS_BIG, DFF, 0, (float)(1 << FFN_SA2), 1.0f / (float)(1 << (FFN_SA1 + FFN_SB1)), 0}; pg8::gemm_phase<pg8::EpiSwiGLU8, 1>(F.lds, k1_, S_, E_, F.wave); } while (0)
#define FFN8_DOWN(l_, nM_) do { int k2_ = DFF; asm volatile("" : "+s"(k2_)); pg8::Sched S_; S_.init(ws + WS_BIG, ws + W_FD + (size_t)(l_) * 11 * MiB / 2, (nM_), 4, k2_, G, cid, 1); \
          pg8::EpiAct E_{(bf16_t*)(ws + WS_Y), 1024, 0}; pg8::gemm_phase<pg8::EpiAct, 1>(F.lds, k2_, S_, E_, F.wave); } while (0)
#define MOE_GEMM1(l_) MOE_GEMM1D(l_, 0)
#define MOE_GEMM1D(l_, dry_) do { int k1_ = 1024; int dr_ = (dry_); asm volatile("" : "+s"(dr_)); asm volatile("" : "+s"(k1_)); pg8::Sched S_; S_.init(ws + WS_BIG, ws + WS_WMOE + (size_t)(l_) * WM_LAYER, nt_total_, 2 * EFF / 256, k1_, G, cid, 1); S_.tile_exp = texp_; S_.b_estride = (size_t)2 * EFF * 1024; \
          pg8::EpiSwiGLU8 E_{ws + WS_BIG + 66 * MiB, EFF, 0, (float)(1 << MOE_SA2), 1.0f / (float)(1 << (MOE_SA1 + MOE_SB1)), dr_}; pg8::gemm_phase<pg8::EpiSwiGLU8, 1>(F.lds, k1_, S_, E_, F.wave); } while (0)
#define MOE_GEMM2(l_) do { int k2_ = EFF; asm volatile("" : "+s"(k2_)); pg8::Sched S_; S_.init(ws + WS_BIG + 66 * MiB, ws + WS_WMOE + (size_t)(l_) * WM_LAYER + WM_DOFF, nt_total_, 4, k2_, G, cid, 1); S_.tile_exp = texp_; S_.b_estride = (size_t)1024 * EFF; \
          pg8::EpiAct E_{(bf16_t*)(ws + WS_Y), 1024, 0};     pg8::gemm_phase<pg8::EpiAct, 1>(F.lds, k2_, S_, E_, F.wave); } while (0)
#ifdef NO_G1
#define MOE_G1(l_) do {} while (0)
#else
#define MOE_G1(l_) do { if ((REP_MASK >> 20) & 1u) { MOE_GEMM1D(l_, 1); GRID_BAR(); } RUN(12, MOE_GEMM1(l_)); } while (0)
#endif
#ifdef NO_G2
#define MOE_G2(l_) do {} while (0)
#else
#define MOE_G2(l_) RUN(13, MOE_GEMM2(l_))
#endif
#define MOE_BLOCK(l_) do { \
    RUN(11, moe_index_phase(F)); GRID_BAR(); \
    const int* cnts_ = (const int*)(ws + WS_COUNTS); const int nt_total_ = __builtin_amdgcn_readfirstlane(cnts_[5120]); \
    LAS int* texp_ = (LAS int*)(F.lds + 147712); { const int t_ = fresh_tid_w(F.wave); if (t_ < 272) texp_[t_] = cnts_[4096 + t_]; } __syncthreads(); \
    MOE_G1(l_); GRID_BAR(); \
    MOE_G2(l_); GRID_BAR(); } while (0)

__global__ void __launch_bounds__(NTHR, 2) hybrid_fwd(Params prm) {
    extern __shared__ __attribute__((aligned(16))) unsigned char lds_raw[];
    Frame F; F.lds = (LAS unsigned char*)lds_raw; F.tid = threadIdx.x; F.lane = F.tid & 63; F.wave = __builtin_amdgcn_readfirstlane(F.tid >> 6); asm volatile("" : "+s"(F.wave));
    F.G = gridDim.x; { const int bx = blockIdx.x; F.vcu = (F.G % 8 == 0) ? (bx % 8) * (F.G / 8) + bx / 8 : bx; }
    F.P = &prm; F.ws = prm.ws;
    volatile LAS unsigned* xbw = (volatile LAS unsigned*)(F.lds + LDS_CTL_OFF);
    if (F.tid < 4) xbw[F.tid] = 0u;
    __syncthreads();
    XcdBarrier bar = xcd_barrier_post((unsigned*)(F.ws + WS_CTL) + CW_BAR, xbw); bar.w = F.wave;
    unsigned char* ws = F.ws;
    const int G = F.G, cid = (int)blockIdx.x;
#ifdef DOUBLE_BAR
#define GRID_BAR() do { xcd_barrier(bar); xcd_barrier(bar); } while (0)
#else
#define GRID_BAR() xcd_barrier(bar)
#endif

    RUN(0, p0_prologue(F));
    GRID_BAR();
    norm1_phase(F);
    GRID_BAR();
#if STOP_AFTER >= 1
    RUN(1, GEMM_ACT(ws + WS_H, ws + W_GIN, MT / 256, 16, 1024, ws + WS_BIG, 4096, 4096));
    SLACK_CONV(0);
    GRID_BAR();
    RUN(2, vstats_phase(F));
    GRID_BAR();
    RUN(2, spatial_phase(F));
    GRID_BAR();
    RUN(3, GEMM_ACT(ws + WS_BIG + 260 * MiB, ws + W_GOUT, MT / 256, 4, 2048, ws + WS_Y, 1024, 0));
    SLACK_CONV(1);
    GRID_BAR();
    if ((REP_MASK >> 19) & 1u) { int dry_ = 1; asm volatile("" : "+s"(dry_)); post_phase<false, false, true, true, (FFN8_MASK & 1) != 0>(F, 0, 1, dry_ != 0); GRID_BAR(); }
    post_phase<false, false, true, true, (FFN8_MASK & 1) != 0>(F, 0, 1);
    GRID_BAR();
#endif
#if STOP_AFTER >= 2
#if FFN8_MASK & 1
    RUN(4, FFN8_UP(0, MT / 256));
    SLACK_CONV(2);
    GRID_BAR();
    RUN(5, FFN8_DOWN(0, MT / 256));
    SLACK_CONV(3);
#else
    RUN(4, GEMM_SWIGLU(ws + WS_H, ws + W_FGU, MT / 256, 2 * DFF / 256, 1024, ws + WS_BIG, DFF));
    SLACK_CONV(2);
    GRID_BAR();
    RUN(5, GEMM_ACT(ws + WS_BIG, ws + W_FD, MT / 256, 4, DFF, ws + WS_Y, 1024, 0));
    SLACK_CONV(3);
#endif
    GRID_BAR();
    if ((REP_MASK >> 19) & 1u) { int dry_ = 1; asm volatile("" : "+s"(dry_)); post_phase<false, false, true, true, LIN8 != 0>(F, 0, 2, dry_ != 0); GRID_BAR(); }
    post_phase<false, false, true, true, LIN8 != 0>(F, 0, 2);
    GRID_BAR();
#endif
#if STOP_AFTER >= 3
#if LIN8
    { int kl = 1024; asm volatile("" : "+s"(kl));
      RUN(6, { pg8::Sched S_; S_.init(ws + WS_H, ws + W_LIN, MT / 256, 8, kl, G, cid, 1); pg8::EpiActS E_{(bf16_t*)(ws + WS_BIG), 2048, 1024, 1.0f / (float)(1 << (FFN_SA1 + FFN_SB1))}; pg8::gemm_phase<pg8::EpiActS, 1>(F.lds, kl, S_, E_, F.wave); }); }
#else
    RUN(6, GEMM_ACT(ws + WS_H, ws + W_LIN, MT / 256, 8, 1024, ws + WS_BIG, 2048, 1024));
#endif
    SLACK_CONV(4);
    GRID_BAR();
    RUN(7, lru_gates_phase(F));
    GRID_BAR();
    RUN(8, lru_carry_phase(F));
    if (G == 256 && F.vcu >= 8) conv_slot(F, 5, F.vcu - 8);
    GRID_BAR();
    RUN(9, lru_scan_phase(F));
    GRID_BAR();
    RUN(10, GEMM_ACT(ws + WS_H, ws + W_LOUT, ML / 256, 4, 1024, ws + WS_Y, 1024, 0));
    GRID_BAR();
    if ((REP_MASK >> 19) & 1u) { int dry_ = 1; asm volatile("" : "+s"(dry_)); post_phase<false, true, true, false, true>(F, 1, 1, dry_ != 0); GRID_BAR(); }
    post_phase<false, true, true, false, true>(F, 1, 1);
    GRID_BAR();
#endif
#if STOP_AFTER >= 4
    MOE_BLOCK(0);
    if ((REP_MASK >> 19) & 1u) { int dry_ = 1; asm volatile("" : "+s"(dry_)); post_phase<true, false, true, false, HIN8 != 0>(F, 1, 2, dry_ != 0); GRID_BAR(); }
    post_phase<true, false, true, false, HIN8 != 0>(F, 1, 2);
    GRID_BAR();
#endif
#if STOP_AFTER >= 5
#if HIN8
    { int kh = 1024; asm volatile("" : "+s"(kh));
      RUN(14, { pg8::Sched S_; S_.init(ws + WS_H, ws + W_HIN, ML / 256, 12, kh, G, cid, 1); pg8::EpiAct E_{(bf16_t*)(ws + WS_BIG), 3072, 0}; pg8::gemm_phase<pg8::EpiAct, 1>(F.lds, kh, S_, E_, F.wave); }); }
#else
    RUN(14, GEMM_ACT(ws + WS_H, ws + W_HIN, ML / 256, 12, 1024, ws + WS_BIG, 3072, 0));
#endif
    { int kf = 256; asm volatile("" : "+s"(kf));
      RUN(14, { pg8::Sched S_; S_.init(ws + WS_HYW, ws + WS_HQ, 8, 128, kf, G, cid); pg8::EpiFilt E_{(bf16_t*)(ws + WS_Y)}; pg8::gemm_phase(F.lds, kf, S_, E_, F.wave); }); }
    GRID_BAR();
    RUN(15, hy_pack_phase(F));
    GRID_BAR();
    RUN(16, hy_fft_phase(F));
    GRID_BAR();
    RUN(17, hy_unpack_phase(F));
    GRID_BAR();
    RUN(10, GEMM_ACT(ws + WS_H, ws + W_HOUT, ML / 256, 4, 1024, ws + WS_Y, 1024, 0));
    GRID_BAR();
    if ((REP_MASK >> 19) & 1u) { int dry_ = 1; asm volatile("" : "+s"(dry_)); post_phase<false, false, true, false, (FFN8_MASK & 2) != 0>(F, 2, 1, dry_ != 0); GRID_BAR(); }
    post_phase<false, false, true, false, (FFN8_MASK & 2) != 0>(F, 2, 1);
    GRID_BAR();
#endif
#if STOP_AFTER >= 6
#if FFN8_MASK & 2
    RUN(4, FFN8_UP(1, ML / 256));
    GRID_BAR();
    RUN(5, FFN8_DOWN(1, ML / 256));
#else
    RUN(4, GEMM_SWIGLU(ws + WS_H, ws + W_FGU + 11 * MiB, ML / 256, 2 * DFF / 256, 1024, ws + WS_BIG, DFF));
    GRID_BAR();
    RUN(5, GEMM_ACT(ws + WS_BIG, ws + W_FD + 11 * MiB / 2, ML / 256, 4, DFF, ws + WS_Y, 1024, 0));
#endif
    GRID_BAR();
    if ((REP_MASK >> 19) & 1u) { int dry_ = 1; asm volatile("" : "+s"(dry_)); post_phase<false, false, true, false, PIN8 != 0>(F, 2, 2, dry_ != 0); GRID_BAR(); }
    post_phase<false, false, true, false, PIN8 != 0>(F, 2, 2);
    GRID_BAR();
#endif
#if STOP_AFTER >= 7
#if PIN8
    { int kq = 1024; asm volatile("" : "+s"(kq));
      RUN(10, { pg8::Sched S_; S_.init(ws + WS_H, ws + W_PIN, ML / 256, 4, kq, G, cid, 1); pg8::EpiAct E_{(bf16_t*)(ws + WS_BIG), 1024, 0}; pg8::gemm_phase<pg8::EpiAct, 1>(F.lds, kq, S_, E_, F.wave); }); }
#else
    RUN(10, GEMM_ACT(ws + WS_H, ws + W_PIN, ML / 256, 4, 1024, ws + WS_BIG, 1024, 0));
#endif
    GRID_BAR();
    RUN(18, pool_phase(F));
    GRID_BAR();
    RUN(10, GEMM_ACT(ws + WS_BIG + 64 * MiB, ws + W_POUT, ML / 256, 4, 1024, ws + WS_Y, 1024, 0));
    GRID_BAR();
    if ((REP_MASK >> 19) & 1u) { int dry_ = 1; asm volatile("" : "+s"(dry_)); post_phase<false, true, true, false, true>(F, 3, 1, dry_ != 0); GRID_BAR(); }
    post_phase<false, true, true, false, true>(F, 3, 1);
    GRID_BAR();
#endif
#if STOP_AFTER >= 8
    MOE_BLOCK(1);
    if ((REP_MASK >> 19) & 1u) { int dry_ = 1; asm volatile("" : "+s"(dry_)); post_phase<true, false, false, false>(F, 3, 2, dry_ != 0); GRID_BAR(); }
    post_phase<true, false, false, false>(F, 3, 2);
#endif
}

extern "C" void kernel_launch(void* const* d_in, const int* in_sizes, int n_in, void* d_out, int out_size, void* d_ws, size_t ws_size, hipStream_t stream) {
    static int grid = 0;
    if (grid == 0) {
        if (n_in != 46 || out_size != ML * D || ws_size < WS_END) { fprintf(stderr, "kernel_launch: unexpected sizes n_in %d out %d ws %zu (need %zu)\n", n_in, out_size, ws_size, (size_t)WS_END); grid = -1; return; }
        int dev = 0, cus = 0, per_cu = 0;
        if (hipGetDevice(&dev) != hipSuccess || hipDeviceGetAttribute(&cus, hipDeviceAttributeMultiprocessorCount, dev) != hipSuccess) { grid = -1; return; }
        if (hipFuncSetAttribute((const void*)hybrid_fwd, hipFuncAttributeMaxDynamicSharedMemorySize, LDS_BYTES) != hipSuccess) { fprintf(stderr, "kernel_launch: hipFuncSetAttribute failed\n"); grid = -1; return; }
        if (hipOccupancyMaxActiveBlocksPerMultiprocessor(&per_cu, (const void*)hybrid_fwd, NTHR, LDS_BYTES) != hipSuccess || per_cu < 1) { fprintf(stderr, "kernel_launch: occupancy query says %d\n", per_cu); }
        (void)hipGetLastError();
        grid = cus;
        if (grid > 256) grid = 256;
    }
    if (grid < 0) return;
    if (hipMemsetAsync((char*)d_ws + WS_CTL, 0, CTL_ZERO_BYTES, stream) != hipSuccess) return;
    Params p{};
    for (int i = 0; i < 46; ++i) p.in[i] = (const float*)d_in[i];
    p.out = (float*)d_out; p.ws = (unsigned char*)d_ws;
    hipLaunchKernelGGL(hybrid_fwd, dim3(grid), dim3(NTHR), LDS_BYTES, stream, p);
}
```
